# Optimizing an MI355X kernel written in HIP

```python
import jax, jax.numpy as jnp
from jax import lax
import numpy as np

D_MODEL = 1024
BATCH = 8
SEQ = 8192
DEPTH = 4

D_MIX = D_MODEL
N_MIXERS = 4
D_GROUP = D_MIX // N_MIXERS
HEAD_DIM = 64
N_HEADS = D_GROUP // HEAD_DIM
CONF_KERNEL = 31
SHORT_KERNEL = 3
POOL_WINDOWS = (2, 4, 8, 16)
POOL_GROUP = D_GROUP // len(POOL_WINDOWS)
CHUNK = 128
D_FF = 2816
N_IN_PIECES = 8
D_IN = N_IN_PIECES * D_GROUP
FFN_RESIDUAL = 0.5
EPS = 1e-6

kernel_name = "hybrid_macaron_parallel_conv_pool_gmlp"


def rmsnorm(x, g):
    xf = x.astype(jnp.float32)
    y = xf * lax.rsqrt(jnp.mean(xf * xf, axis=-1, keepdims=True) + EPS)
    return (y * g.astype(jnp.float32)).astype(x.dtype)


def layernorm(x, g, b):
    xf = x.astype(jnp.float32)
    mu = jnp.mean(xf, axis=-1, keepdims=True)
    xc = xf - mu
    y = xc * lax.rsqrt(jnp.mean(xc * xc, axis=-1, keepdims=True) + EPS)
    return (y * g.astype(jnp.float32) + b.astype(jnp.float32)).astype(x.dtype)


def causal_depthwise_conv(x, w):
    k, c = w.shape
    return lax.conv_general_dilated(
        x, w[:, None, :].astype(x.dtype), window_strides=(1,), padding=[(k - 1, 0)],
        dimension_numbers=("NWC", "WIO", "NWC"), feature_group_count=c)


def swiglu(h, w1, w3, w2):
    return (jax.nn.silu(h @ w1) * (h @ w3)) @ w2


def conformer_conv(val, gate, conv_w, conv_b, ln_g, ln_b):
    y = val * jax.nn.sigmoid(gate)
    y = causal_depthwise_conv(y, conv_w) + conv_b
    return jax.nn.silu(layernorm(y, ln_g, ln_b))


def short_gated_conv(b_gate, c_gate, xv, conv_w):
    return b_gate * causal_depthwise_conv(c_gate * xv, conv_w)


def multiscale_pool(xp, pool_w, pool_scale):
    bsz, s, _ = xp.shape
    xf = xp.astype(jnp.float32)
    cs = jnp.cumsum(xf, axis=1)
    pos = jnp.arange(1, s + 1, dtype=jnp.float32)[:, None]
    outs = []
    for g, w in enumerate(POOL_WINDOWS):
        sl = slice(g * POOL_GROUP, (g + 1) * POOL_GROUP)
        c = cs[..., sl]
        lagged = jnp.pad(c, ((0, 0), (w, 0), (0, 0)))[:, :s]
        mean = (c - lagged) / jnp.minimum(pos, float(w))
        outs.append(mean - xf[..., sl])
    d = jnp.stack(outs, axis=2).astype(xp.dtype)
    y = jnp.einsum("bsgc,gcd->bsgd", d, pool_w).reshape(bsz, s, D_GROUP)
    return y * pool_scale


def chunked_spatial_gating(u, v, ln_g, ln_b, w_s, b_s):
    bsz, s, _ = v.shape
    v = layernorm(v, ln_g, ln_b)
    vc = v.reshape(bsz, s // CHUNK, CHUNK, N_HEADS, HEAD_DIM)
    mask = jnp.tril(jnp.ones((CHUNK, CHUNK), dtype=bool))
    ws = jnp.where(mask[None], w_s, 0.0).astype(v.dtype)
    mixed = jnp.einsum("hts,bnshc->bnthc", ws, vc) + b_s.T[None, None, :, :, None]
    return u * mixed.reshape(bsz, s, D_GROUP)


def setup_inputs(seed: int = 0) -> dict:
    key = jax.random.key(seed)
    ks = iter(jax.random.split(key, 32))

    def nrm(shape, scale):
        return jax.random.normal(next(ks), shape, dtype=jnp.float32) * scale

    def gain(shape):
        return 1.0 + nrm(shape, 0.02)

    L = DEPTH
    return {
        "x": nrm((BATCH, SEQ, D_MODEL), 1.0),
        "ffn1_norm": gain((L, D_MODEL)),
        "ffn1_w1": nrm((L, D_MODEL, D_FF), D_MODEL ** -0.5),
        "ffn1_w3": nrm((L, D_MODEL, D_FF), D_MODEL ** -0.5),
        "ffn1_w2": nrm((L, D_FF, D_MODEL), D_FF ** -0.5),
        "mix_norm": gain((L, D_MODEL)),
        "w_in": nrm((L, D_MODEL, D_IN), D_MODEL ** -0.5),
        "conf_conv_w": nrm((L, CONF_KERNEL, D_GROUP), CONF_KERNEL ** -0.5),
        "conf_conv_b": nrm((L, D_GROUP), 0.02),
        "conf_ln_g": gain((L, D_GROUP)),
        "conf_ln_b": nrm((L, D_GROUP), 0.02),
        "sconv_w": nrm((L, SHORT_KERNEL, D_GROUP), SHORT_KERNEL ** -0.5),
        "pool_w": nrm((L, len(POOL_WINDOWS), POOL_GROUP, POOL_GROUP), POOL_GROUP ** -0.5),
        "pool_scale": 1.0 + nrm((L, D_GROUP), 0.1),
        "gmlp_ln_g": gain((L, D_GROUP)),
        "gmlp_ln_b": nrm((L, D_GROUP), 0.02),
        "gmlp_w_s": nrm((L, N_HEADS, CHUNK, CHUNK), CHUNK ** -0.5),
        "gmlp_b_s": 1.0 + nrm((L, N_HEADS, CHUNK), 0.02),
        "w_out": nrm((L, D_MIX, D_MODEL), D_MIX ** -0.5),
        "ffn2_norm": gain((L, D_MODEL)),
        "ffn2_w1": nrm((L, D_MODEL, D_FF), D_MODEL ** -0.5),
        "ffn2_w3": nrm((L, D_MODEL, D_FF), D_MODEL ** -0.5),
        "ffn2_w2": nrm((L, D_FF, D_MODEL), D_FF ** -0.5),
        "final_norm": gain((D_MODEL,)),
    }


def reference(x, ffn1_norm, ffn1_w1, ffn1_w3, ffn1_w2, mix_norm, w_in,
              conf_conv_w, conf_conv_b, conf_ln_g, conf_ln_b, sconv_w,
              pool_w, pool_scale, gmlp_ln_g, gmlp_ln_b, gmlp_w_s, gmlp_b_s,
              w_out, ffn2_norm, ffn2_w1, ffn2_w3, ffn2_w2, final_norm):
    for l in range(DEPTH):
        h = rmsnorm(x, ffn1_norm[l])
        x = x + FFN_RESIDUAL * swiglu(h, ffn1_w1[l], ffn1_w3[l], ffn1_w2[l])

        h = rmsnorm(x, mix_norm[l])
        p = h @ w_in[l]
        a_val, a_gate, s_b, s_c, s_x, pool_in, g_u, g_v = jnp.split(p, N_IN_PIECES, axis=-1)

        y_a = conformer_conv(a_val, a_gate, conf_conv_w[l], conf_conv_b[l],
                             conf_ln_g[l], conf_ln_b[l])
        y_b = short_gated_conv(s_b, s_c, s_x, sconv_w[l])
        y_c = multiscale_pool(pool_in, pool_w[l], pool_scale[l])
        y_d = chunked_spatial_gating(g_u, g_v, gmlp_ln_g[l], gmlp_ln_b[l],
                                     gmlp_w_s[l], gmlp_b_s[l])

        mix = jnp.concatenate([y_a, y_b, y_c, y_d], axis=-1)
        x = x + mix @ w_out[l]

        h = rmsnorm(x, ffn2_norm[l])
        x = x + FFN_RESIDUAL * swiglu(h, ffn2_w1[l], ffn2_w3[l], ffn2_w2[l])

    return rmsnorm(x, final_norm)
```

```cpp
#include <hip/hip_runtime.h>
#include <hip/hip_cooperative_groups.h>
#include <cstdio>
#include <cstdint>
namespace pg8 {
#define PG8_LAS __attribute__((address_space(3)))
typedef unsigned short bf16_t;
typedef short bf16x8 __attribute__((ext_vector_type(8)));
typedef float f32x4 __attribute__((ext_vector_type(4)));
typedef unsigned u32x4 __attribute__((ext_vector_type(4)));
constexpr int BM = 256, BK = 64, HALF = 128, HTB = HALF * BK * 2  , STAGE_BYTES = 8 * HTB, NXCD = 8, WGM = 4;

__host__ __device__ __forceinline__ int lds_byte(int r, int c) { const int st = (r >> 4) * 2 + (c >> 5), rr = r & 15, cc = c & 31, ob = rr * 64 + cc * 2; return st * 1024 + (ob ^ (((ob >> 9) & 1) << 5)); }
__host__ __device__ __forceinline__ void stage_rc(int b, int& R, int& C) { const int st = b / 1024, sb = b % 1024, swz = sb ^ (((sb >> 9) & 1) << 5); R = (st >> 1) * 16 + swz / 64; C = (st & 1) * 32 + (swz % 64) / 2; }
__host__ __device__ __forceinline__ int perm32(int rho) { const int n = rho >> 4, i = rho & 15; return 8 * (i >> 2) + 4 * n + (i & 3); }

struct Unit { int pm, pn; };
struct Gemm { const bf16_t* A; const bf16_t* Bt; int M, N, K; int pm_mask = -1, pn_mask = -1; };

struct StaticOrder {
    int nM, nN, nwg, G, c; int wgm = WGM;
    __host__ __device__ void init(int M, int N, int G_, int c_) { nM = M / BM; nN = N / BM; nwg = nM * nN; G = G_; c = c_; }
    __host__ __device__ bool next(int i, Unit& u) const {
        const long L = (long)i * G + c; if (L >= nwg) return false;
        int wgid = (int)L; { const int q = nwg / NXCD, r = nwg % NXCD, xcd = wgid % NXCD, off = wgid / NXCD; wgid = (xcd < r ? xcd * (q + 1) : r * (q + 1) + (xcd - r) * q) + off; }
        const int nig = wgm * nN, gid = wgid / nig, fm = gid * wgm, gsz = (nM - fm) < wgm ? (nM - fm) : wgm;
        u.pm = fm + ((wgid % nig) % gsz); u.pn = (wgid % nig) / gsz; return true;
    }
    __device__ __forceinline__ void a_ready(const Unit&) const {}
    __device__ __forceinline__ void done(const Unit&) const {}
};
__device__ __forceinline__ unsigned cvt_pk_bf16(float lo, float hi) { unsigned r; asm("v_cvt_pk_bf16_f32 %0, %1, %2" : "=v"(r) : "v"(lo), "v"(hi)); return r; }
typedef float f32x2 __attribute__((ext_vector_type(2)));
typedef unsigned u32x2 __attribute__((ext_vector_type(2)));
constexpr float RMS_EPS = 1e-6f;
__device__ __forceinline__ unsigned long long ss_fix(float q) { return (unsigned long long)(q * 1048576.0f + 0.5f); }
__device__ __forceinline__ float ss_rnorm(unsigned long long s) { return __builtin_amdgcn_rsqf((float)s * (1.0f / (1048576.0f * 1024.0f)) + RMS_EPS); }
__device__ __forceinline__ float fast_sigmoid(float g) { return __builtin_amdgcn_rcpf(1.0f + __builtin_amdgcn_exp2f(-1.4426950408889634f * g)); }
__device__ __forceinline__ float fast_silu(float a) { return a * fast_sigmoid(a); }

struct EpiSwiglu {
    static constexpr bool PERM = true, AFTER_DRAIN = false;
    bf16_t* U; const unsigned long long* ss; int cheap;
    __device__ __forceinline__ void operator()(const f32x4 (&acc)[2][2][4][2], const Unit& u, int wr, int wc, int fr, int fq) const {
        const int row0 = u.pm * BM + wr * 64 + fr, col0 = u.pn * HALF + wc * 32 + 8 * fq;
#pragma unroll
        for (int ai = 0; ai < 2; ++ai)
#pragma unroll
            for (int m = 0; m < 4; ++m) { const int row = row0 + ai * HALF + m * 16;
                float o[8];
                if (cheap) {
#pragma unroll
                    for (int n = 0; n < 2; ++n)
#pragma unroll
                        for (int j = 0; j < 4; ++j) o[4 * n + j] = acc[ai][0][m][n][j] + acc[ai][1][m][n][j];
                } else {
                const float r = ss_rnorm(ss[row]), r2 = r * -1.4426950408889634f;
                float av[8], bv[8], tv[8];
#pragma unroll
                for (int n = 0; n < 2; ++n)
#pragma unroll
                    for (int j = 0; j < 4; ++j) { av[4 * n + j] = acc[ai][0][m][n][j] * r; bv[4 * n + j] = acc[ai][1][m][n][j] * r; tv[4 * n + j] = acc[ai][0][m][n][j] * r2; }
#pragma unroll
                for (int i = 0; i < 8; ++i) tv[i] = __builtin_amdgcn_exp2f(tv[i]);
#pragma unroll
                for (int i = 0; i < 8; ++i) tv[i] = __builtin_amdgcn_rcpf(1.0f + tv[i]);
#pragma unroll
                for (int i = 0; i < 8; ++i) o[i] = (av[i] * tv[i]) * bv[i]; }
                u32x4 w; w.x = cvt_pk_bf16(o[0], o[1]); w.y = cvt_pk_bf16(o[2], o[3]); w.z = cvt_pk_bf16(o[4], o[5]); w.w = cvt_pk_bf16(o[6], o[7]);
                *(u32x4*)(U + (size_t)row * 2816 + col0) = w; }
    }
};
struct EpiScale {
    static constexpr bool PERM = true, AFTER_DRAIN = false;
    bf16_t* O; int ldc; const unsigned long long* ss;
    __device__ __forceinline__ void operator()(const f32x4 (&acc)[2][2][4][2], const Unit& u, int wr, int wc, int fr, int fq) const {
        const int row0 = u.pm * BM + wr * 64 + fr, col0 = u.pn * BM + wc * 32 + 8 * fq;
#pragma unroll
        for (int ai = 0; ai < 2; ++ai)
#pragma unroll
            for (int m = 0; m < 4; ++m) { const int row = row0 + ai * HALF + m * 16;
                const float r = ss_rnorm(ss[row]);
                bf16_t* rowp = O + (size_t)row * ldc + col0;
#pragma unroll
                for (int bj = 0; bj < 2; ++bj) { const f32x4 v0 = acc[ai][bj][m][0] * r, v1 = acc[ai][bj][m][1] * r;
                    u32x4 w; w.x = cvt_pk_bf16(v0[0], v0[1]); w.y = cvt_pk_bf16(v0[2], v0[3]); w.z = cvt_pk_bf16(v1[0], v1[1]); w.w = cvt_pk_bf16(v1[2], v1[3]);
                    *(u32x4*)(rowp + bj * HALF) = w; } }
    }
};
struct EpiResid {
    static constexpr bool PERM = true, AFTER_DRAIN = false;
    bf16_t* xb; unsigned long long* ssout; float scale; int dry;
    __device__ __forceinline__ void operator()(const f32x4 (&acc)[2][2][4][2], const Unit& u, int wr, int wc, int fr, int fq) const {
        const int row0 = u.pm * BM + wr * 64 + fr, col0 = u.pn * BM + wc * 32 + 8 * fq; const float scale = dry ? 0.f : this->scale;
        u32x4 xr[2][4][2];
#pragma unroll
        for (int ai = 0; ai < 2; ++ai)
#pragma unroll
            for (int m = 0; m < 4; ++m)
#pragma unroll
                for (int bj = 0; bj < 2; ++bj) xr[ai][m][bj] = *(const u32x4*)(xb + (size_t)(row0 + ai * HALF + m * 16) * 1024 + col0 + bj * HALF);
#pragma unroll
        for (int ai = 0; ai < 2; ++ai)
#pragma unroll
            for (int m = 0; m < 4; ++m) { const int row = row0 + ai * HALF + m * 16; const size_t off = (size_t)row * 1024 + col0;
                float q = 0.f;
#pragma unroll
                for (int bj = 0; bj < 2; ++bj) {
                    const u32x4 xv = xr[ai][m][bj];
                    const f32x4 x0 = (f32x4){__uint_as_float(xv.x << 16), __uint_as_float(xv.x & 0xffff0000u), __uint_as_float(xv.y << 16), __uint_as_float(xv.y & 0xffff0000u)};
                    const f32x4 x1 = (f32x4){__uint_as_float(xv.z << 16), __uint_as_float(xv.z & 0xffff0000u), __uint_as_float(xv.w << 16), __uint_as_float(xv.w & 0xffff0000u)};
                    const f32x4 y0 = x0 + acc[ai][bj][m][0] * scale, y1 = x1 + acc[ai][bj][m][1] * scale;
                    u32x4 w; w.x = cvt_pk_bf16(y0[0], y0[1]); w.y = cvt_pk_bf16(y0[2], y0[3]); w.z = cvt_pk_bf16(y1[0], y1[1]); w.w = cvt_pk_bf16(y1[2], y1[3]);
                    *(u32x4*)(xb + off + bj * HALF) = w;
                    q += (y0[0] * y0[0] + y0[1] * y0[1]) + (y0[2] * y0[2] + y0[3] * y0[3]) + (y1[0] * y1[0] + y1[1] * y1[1]) + (y1[2] * y1[2] + y1[3] * y1[3]); }
                q += __shfl_xor(q, 16); q += __shfl_xor(q, 32);
                if (fq == 0 && !dry) atomicAdd(ssout + row, ss_fix(q)); }
    }
};
template <class Epi, class Sched, bool ALIGN_EPI = false, bool SP2 = false>
__device__ __forceinline__ void gemm_phase(PG8_LAS unsigned char* lds, const Gemm g, const Sched& S, const Epi& E) {
    int tid_l = threadIdx.x; asm volatile("" : "+v"(tid_l));
    const int tid = tid_l, wid = __builtin_amdgcn_readfirstlane(tid >> 6), lane = tid & 63, wr = wid >> 2, wc = wid & 3, fr = lane & 15, fq = lane >> 4;
    const int K = g.K, nt = K / BK;
    unsigned voffA[2], voffB[2];
#pragma unroll
    for (int i = 0; i < 2; ++i) { int R, C; stage_rc(tid * 16 + i * 8192, R, C); const int Rb = Epi::PERM ? ((R & ~31) + perm32(R & 31)) : R;
        voffA[i] = (unsigned)(R * K + C) * 2u; voffB[i] = (unsigned)(Rb * K + C) * 2u; }
    const size_t kstep = (size_t)(BK * 2);
    const size_t hstep = (size_t)HALF * K * 2;
    const size_t tstep = 2 * hstep;
    const unsigned ldsw = (unsigned)wid * 1024u;
    const int aoff = lds_byte(wr * 64 + fr, fq * 8), boff = lds_byte(wc * 32 + fr, fq * 8);
#define PG8_SA(b, h) (((b) * 2 + (h)) * HTB)
#define PG8_SB(b, h) ((4 + (b) * 2 + (h)) * HTB)
#define PG8_STAGE(bufoff, gbase, voff) do { _Pragma("unroll") for (int _i = 0; _i < 2; ++_i) \
        __builtin_amdgcn_global_load_lds((const unsigned*)((const char*)(gbase) + (voff)[_i]), (PG8_LAS unsigned*)(lds + (bufoff) + ldsw + _i * 8192), 16, 0, 0); } while (0)
#define PG8_LDA(dst, b, h) do { _Pragma("unroll") for (int m = 0; m < 4; ++m) _Pragma("unroll") for (int k = 0; k < 2; ++k) dst[m][k] = *(const PG8_LAS bf16x8*)(lds + PG8_SA(b, h) + aoff + m * 2048 + k * 1024); } while (0)
#define PG8_LDB(dst, b, h) do { _Pragma("unroll") for (int n = 0; n < 2; ++n) _Pragma("unroll") for (int k = 0; k < 2; ++k) dst[n][k] = *(const PG8_LAS bf16x8*)(lds + PG8_SB(b, h) + boff + n * 2048 + k * 1024); } while (0)
#define PG8_MMA(ai, bj, At, Bt) do { __builtin_amdgcn_s_setprio(1); _Pragma("unroll") for (int m = 0; m < 4; ++m) _Pragma("unroll") for (int n = 0; n < 2; ++n) _Pragma("unroll") for (int k = 0; k < 2; ++k) \
        acc[ai][bj][m][n] = __builtin_amdgcn_mfma_f32_16x16x32_bf16(Bt[n][k], At[m][k], acc[ai][bj][m][n], 0, 0, 0); __builtin_amdgcn_s_setprio(0); } while (0)
#define PG8_WAIT_V(n) asm volatile("s_waitcnt vmcnt(" #n ")" ::: "memory")
#define PG8_WAIT_L(n) asm volatile("s_waitcnt lgkmcnt(" #n ")" ::: "memory")
#define PG8_BAR __builtin_amdgcn_s_barrier()
#define PG8_SCHED __builtin_amdgcn_sched_barrier(0)
    Unit cur, nxt; int ui = 0;
    if (!S.next(0, cur)) return;
    f32x4 acc[2][2][4][2];
#pragma unroll
    for (int a = 0; a < 2; ++a)
#pragma unroll
        for (int b = 0; b < 2; ++b)
#pragma unroll
            for (int m = 0; m < 4; ++m)
#pragma unroll
                for (int n = 0; n < 2; ++n) acc[a][b][m][n] = (f32x4){0.f, 0.f, 0.f, 0.f};
    bf16x8 At[4][2], B0[2][2], B1[2][2];
    const char* cA = (const char*)g.A + (size_t)(cur.pm & g.pm_mask) * tstep; const char* cB = (const char*)g.Bt + (size_t)(cur.pn & g.pn_mask) * tstep;
    S.a_ready(cur);
    if constexpr (SP2) {
        PG8_STAGE(PG8_SB(0, 0), cB, voffB); PG8_STAGE(PG8_SB(0, 1), cB + hstep, voffB); PG8_STAGE(PG8_SA(0, 0), cA, voffA); PG8_STAGE(PG8_SA(0, 1), cA + hstep, voffA);
        if (wr == 1) PG8_BAR;
        PG8_WAIT_V(2); PG8_BAR;
        PG8_STAGE(PG8_SB(1, 0), cB + kstep, voffB); PG8_STAGE(PG8_SA(1, 0), cA + kstep, voffA); PG8_STAGE(PG8_SB(1, 1), cB + hstep + kstep, voffB);
        PG8_WAIT_V(6); PG8_BAR;
    } else {
        PG8_STAGE(PG8_SB(0, 0), cB, voffB); PG8_STAGE(PG8_SA(0, 0), cA, voffA); PG8_STAGE(PG8_SB(0, 1), cB + hstep, voffB); PG8_STAGE(PG8_SA(0, 1), cA + hstep, voffA);
        if (wr == 1) PG8_BAR;
        PG8_WAIT_V(4); PG8_BAR;
        PG8_STAGE(PG8_SB(1, 0), cB + kstep, voffB); PG8_STAGE(PG8_SA(1, 0), cA + kstep, voffA); PG8_STAGE(PG8_SB(1, 1), cB + hstep + kstep, voffB);
        PG8_WAIT_V(6); PG8_BAR;
    }
    for (;;) {
        const bool has_next = S.next(ui + 1, nxt);
        const char* nA = has_next ? (const char*)g.A + (size_t)(nxt.pm & g.pm_mask) * tstep : cA; const char* nB = has_next ? (const char*)g.Bt + (size_t)(nxt.pn & g.pn_mask) * tstep : cB;
        for (int t = 0; t < nt; t += 2) {
            const bool last = (t == nt - 2);
            const char* a1 = cA + (size_t)(t + 1) * kstep;
            const char* a2 = last ? nA : cA + (size_t)(t + 2) * kstep; const char* b2 = last ? nB : cB + (size_t)(t + 2) * kstep;
            const char* a3 = a2 + kstep; const char* b3 = b2 + kstep;
            if (last && has_next) S.a_ready(nxt);
            if constexpr (SP2) {
            PG8_LDB(B0, 0, 0); PG8_LDB(B1, 0, 1); PG8_SCHED; PG8_LDA(At, 0, 0); PG8_STAGE(PG8_SA(1, 1), a1 + hstep, voffA);
            PG8_WAIT_V(8); PG8_WAIT_L(0); PG8_BAR; PG8_MMA(0, 0, At, B0); PG8_MMA(0, 1, At, B1); PG8_BAR; PG8_SCHED;
            PG8_LDA(At, 0, 1); PG8_STAGE(PG8_SB(0, 0), b2, voffB); PG8_STAGE(PG8_SB(0, 1), b2 + hstep, voffB); PG8_STAGE(PG8_SA(0, 0), a2, voffA);
            PG8_WAIT_V(8); PG8_WAIT_L(0); PG8_BAR; PG8_MMA(1, 0, At, B0); PG8_MMA(1, 1, At, B1); PG8_BAR; PG8_SCHED;
            PG8_LDB(B0, 1, 0); PG8_LDB(B1, 1, 1); PG8_SCHED; PG8_LDA(At, 1, 0); PG8_STAGE(PG8_SA(0, 1), a2 + hstep, voffA);
            PG8_WAIT_V(8); PG8_WAIT_L(0); PG8_BAR; PG8_MMA(0, 0, At, B0); PG8_MMA(0, 1, At, B1); PG8_BAR; PG8_SCHED;
            PG8_LDA(At, 1, 1); PG8_STAGE(PG8_SB(1, 0), b3, voffB); PG8_STAGE(PG8_SB(1, 1), b3 + hstep, voffB); PG8_STAGE(PG8_SA(1, 0), a3, voffA);
            PG8_WAIT_V(8); PG8_WAIT_L(0); PG8_BAR; PG8_MMA(1, 0, At, B0); PG8_MMA(1, 1, At, B1); PG8_BAR; PG8_SCHED;
            } else {
            PG8_LDB(B0, 0, 0); PG8_SCHED; PG8_LDA(At, 0, 0); PG8_STAGE(PG8_SA(1, 1), a1 + hstep, voffA);
            PG8_WAIT_L(8); PG8_BAR; PG8_WAIT_L(0); PG8_MMA(0, 0, At, B0); PG8_BAR; PG8_SCHED;
            PG8_LDB(B1, 0, 1); PG8_STAGE(PG8_SB(0, 0), b2, voffB);
            PG8_BAR; PG8_WAIT_L(0); PG8_MMA(0, 1, At, B1); PG8_BAR;
            PG8_LDA(At, 0, 1); PG8_STAGE(PG8_SA(0, 0), a2, voffA);
            PG8_BAR; PG8_WAIT_L(0); PG8_MMA(1, 0, At, B0); PG8_BAR; PG8_SCHED;
            PG8_STAGE(PG8_SB(0, 1), b2 + hstep, voffB);
            PG8_WAIT_V(6); PG8_BAR; PG8_MMA(1, 1, At, B1); PG8_BAR;
            PG8_LDB(B0, 1, 0); PG8_SCHED; PG8_LDA(At, 1, 0); PG8_STAGE(PG8_SA(0, 1), a2 + hstep, voffA);
            PG8_WAIT_L(8); PG8_BAR; PG8_WAIT_L(0); PG8_MMA(0, 0, At, B0); PG8_BAR; PG8_SCHED;
            PG8_LDB(B1, 1, 1); PG8_STAGE(PG8_SB(1, 0), b3, voffB);
            PG8_BAR; PG8_WAIT_L(0); PG8_MMA(0, 1, At, B1); PG8_BAR;
            PG8_LDA(At, 1, 1); PG8_STAGE(PG8_SA(1, 0), a3, voffA);
            PG8_BAR; PG8_WAIT_L(0); PG8_MMA(1, 0, At, B0); PG8_BAR; PG8_SCHED;
            PG8_STAGE(PG8_SB(1, 1), b3 + hstep, voffB);
            PG8_WAIT_V(6); PG8_BAR; PG8_MMA(1, 1, At, B1); PG8_BAR;
            }
        }
        if constexpr (ALIGN_EPI) { if (wr == 0) PG8_BAR; }
        if constexpr (!Epi::AFTER_DRAIN) { E(acc, cur, wr, wc, fr, fq); S.done(cur); }
        if (!has_next) break;
#pragma unroll
        for (int a = 0; a < 2; ++a)
#pragma unroll
            for (int b = 0; b < 2; ++b)
#pragma unroll
                for (int m = 0; m < 4; ++m)
#pragma unroll
                    for (int n = 0; n < 2; ++n) acc[a][b][m][n] = (f32x4){0.f, 0.f, 0.f, 0.f};
        cur = nxt; cA = nA; cB = nB; ++ui;
        if constexpr (ALIGN_EPI) { if (wr == 1) PG8_BAR; }
    }
    PG8_WAIT_V(0);
    if constexpr (!ALIGN_EPI) { if (wr == 0) PG8_BAR; }
    PG8_BAR;
    if constexpr (Epi::AFTER_DRAIN) { E.fused(acc, cur, wr, wc, fr, fq, lds, wid, lane); S.done(cur); }
#undef PG8_SA
#undef PG8_SB
#undef PG8_STAGE
#undef PG8_LDA
#undef PG8_LDB
#undef PG8_MMA
#undef PG8_WAIT_V
#undef PG8_WAIT_L
#undef PG8_BAR
#undef PG8_SCHED
}
}

namespace cg = cooperative_groups;
#define GAS __attribute__((address_space(1)))
#define LAS __attribute__((address_space(3)))
typedef unsigned short bf16;
typedef float f32x4 __attribute__((ext_vector_type(4)));
typedef unsigned u32x4 __attribute__((ext_vector_type(4)));
typedef unsigned u32x2 __attribute__((ext_vector_type(2)));
typedef short bf16x8 __attribute__((ext_vector_type(8)));

constexpr int NT = 512, NWAVES = 8;
constexpr int BATCH = 8, SEQ = 8192, D = 1024, FF = 2816, DIN = 2048, DEPTH = 4, M = BATCH * SEQ, CHUNK = 128;
constexpr int NCHUNK = M / CHUNK;
#ifndef MK_NSPLIT
#define MK_NSPLIT 2
#endif
constexpr int NSPLIT = MK_NSPLIT, MH = M / NSPLIT;
constexpr int NPHASE = DEPTH * 7 * NSPLIT + 2;
constexpr size_t MiB = 1u << 20;
constexpr size_t WS_CTL = 0;
constexpr size_t WS_SS = 1 * MiB;
constexpr size_t WS_POOLT = 8 * MiB;
constexpr size_t WS_WSB = 8 * MiB + 512 * 1024;
constexpr size_t WS_W = 10 * MiB;
constexpr size_t W_LAYER = 39 * MiB;
constexpr size_t WO_13A = 0, WO_2A = WO_13A + (size_t)2 * FF * D * 2, WO_IN = WO_2A + (size_t)D * FF * 2, WO_OUT = WO_IN + (size_t)DIN * D * 2,
                 WO_13B = WO_OUT + (size_t)D * D * 2, WO_2B = WO_13B + (size_t)2 * FF * D * 2;
static_assert(WO_2B + (size_t)D * FF * 2 == W_LAYER, "weight map");
constexpr size_t WS_XB = WS_W + DEPTH * W_LAYER;
constexpr size_t WS_R = WS_XB + (size_t)M * D * 2;
constexpr size_t WS_P = WS_R, WS_MIX = WS_R + (size_t)MH * DIN * 2;
constexpr size_t WS_END = WS_R + (size_t)MH * (DIN + D) * 2;
static_assert((size_t)MH * FF * 2 <= (size_t)MH * (DIN + D) * 2, "U fits the block region");
constexpr int LDS_BYTES = 147456;

struct Args { const float* in[24]; float* out; unsigned char* ws; int ph_lo, ph_hi; };

__device__ __forceinline__ float bf_lo(unsigned w) { return __uint_as_float(w << 16); }
__device__ __forceinline__ float bf_hi(unsigned w) { return __uint_as_float(w & 0xffff0000u); }
__device__ __forceinline__ unsigned f2bf(float f) { unsigned u = __float_as_uint(f); return (u + 0x7fffu + ((u >> 16) & 1u)) >> 16; }
__device__ __forceinline__ unsigned pk2(float lo, float hi) { return pg8::cvt_pk_bf16(lo, hi); }
__device__ __forceinline__ float wave_sum(float v) {
    v += __builtin_bit_cast(float, __builtin_amdgcn_update_dpp(0, __builtin_bit_cast(int, v), 0xB1, 0xf, 0xf, false));
    v += __builtin_bit_cast(float, __builtin_amdgcn_update_dpp(0, __builtin_bit_cast(int, v), 0x4E, 0xf, 0xf, false));
    v += __builtin_bit_cast(float, __builtin_amdgcn_update_dpp(0, __builtin_bit_cast(int, v), 0x141, 0xf, 0xf, false));
    v += __builtin_bit_cast(float, __builtin_amdgcn_update_dpp(0, __builtin_bit_cast(int, v), 0x140, 0xf, 0xf, false));
    v += __shfl_xor(v, 16); v += __shfl_xor(v, 32);
    return v;
}
#define LDS_WAIT() asm volatile("s_waitcnt lgkmcnt(0)" ::: "memory")

__device__ __noinline__ void conv_matrix(const float* __restrict__ W, const float* __restrict__ gain, int K, int N, bf16* __restrict__ WT, int mode, int gtid, int nthr, int half) {
    const int total = (K >> 3) * N, i_lo = half == 1 ? total / 2 : 0, i_hi = half == 0 ? total / 2 : total;
#pragma unroll 2
    for (int i = i_lo + gtid; i < i_hi; i += nthr) { const int k8 = i / N, n = i - k8 * N, k0 = k8 * 8; const float* src = W + (size_t)k0 * N + n;
        float v[8];
#pragma unroll
        for (int e = 0; e < 8; ++e) v[e] = src[(size_t)e * N];
        if (gain) {
#pragma unroll
            for (int e = 0; e < 8; ++e) v[e] *= gain[k0 + e]; }
        const int row = mode == 0 ? n : (256 * (n >> 7) + (n & 127) + (mode == 2 ? 128 : 0));
        u32x4 o; o.x = pk2(v[0], v[1]); o.y = pk2(v[2], v[3]); o.z = pk2(v[4], v[5]); o.w = pk2(v[6], v[7]);
        *(u32x4*)(WT + (size_t)row * K + k0) = o; }
}

__device__ __forceinline__ void conv_layer(const Args& a, int l, int group, int gtid, int nthr, int half) {
    unsigned char* wl = a.ws + WS_W + (size_t)l * W_LAYER; const size_t oUP = (size_t)l * D * FF, oDN = (size_t)l * FF * D;
    if (group != 1) {
        conv_matrix(a.in[2] + oUP, a.in[1] + l * D, D, FF, (bf16*)(wl + WO_13A), 1, gtid, nthr, half);
        conv_matrix(a.in[3] + oUP, a.in[1] + l * D, D, FF, (bf16*)(wl + WO_13A), 2, gtid, nthr, half);
        conv_matrix(a.in[4] + oDN, nullptr, FF, D, (bf16*)(wl + WO_2A), 0, gtid, nthr, half);
        conv_matrix(a.in[6] + (size_t)l * D * DIN, a.in[5] + l * D, D, DIN, (bf16*)(wl + WO_IN), 0, gtid, nthr, half);
        conv_matrix(a.in[18] + (size_t)l * D * D, nullptr, D, D, (bf16*)(wl + WO_OUT), 0, gtid, nthr, half); }
    if (group != 0) {
        conv_matrix(a.in[20] + oUP, a.in[19] + l * D, D, FF, (bf16*)(wl + WO_13B), 1, gtid, nthr, half);
        conv_matrix(a.in[21] + oUP, a.in[19] + l * D, D, FF, (bf16*)(wl + WO_13B), 2, gtid, nthr, half);
        conv_matrix(a.in[22] + oDN, nullptr, FF, D, (bf16*)(wl + WO_2B), 0, gtid, nthr, half); }
}

__device__ __forceinline__ void prologue(const Args& a, LAS unsigned char* lds, int G, int bid, int tid, int wave, int lane) {
    unsigned char* ws = a.ws;
    const int gw = bid * NWAVES + wave, NGW = G * NWAVES;
    { f32x4* z = (f32x4*)(ws + WS_SS + (size_t)M * 8); const int n4 = 12 * M / 2;
      for (int i = bid * NT + tid; i < n4; i += G * NT) z[i] = (f32x4){0.f, 0.f, 0.f, 0.f}; }
    { const float* x = a.in[0]; bf16* xb = (bf16*)(ws + WS_XB); unsigned long long* ss0 = (unsigned long long*)(ws + WS_SS);
      for (int m0 = gw * 4; m0 < M; m0 += NGW * 4) { f32x4 v[4][4];
#pragma unroll
          for (int r = 0; r < 4; ++r)
#pragma unroll
              for (int j = 0; j < 4; ++j) v[r][j] = *((const f32x4*)(x + (size_t)(m0 + r) * D) + lane + 64 * j);
#pragma unroll
          for (int r = 0; r < 4; ++r) { float q = 0.f; u32x2* o8 = (u32x2*)(xb + (size_t)(m0 + r) * D) + lane;
#pragma unroll
              for (int j = 0; j < 4; ++j) { const f32x4 t = v[r][j]; q += (t.x * t.x + t.y * t.y) + (t.z * t.z + t.w * t.w); u32x2 o; o.x = pk2(t.x, t.y); o.y = pk2(t.z, t.w); o8[64 * j] = o; }
              q = wave_sum(q); if (lane == 0) ss0[m0 + r] = pg8::ss_fix(q); } } }
    { const int gtid = bid * NT + tid, nthr = G * NT; const int nl = DEPTH;
      for (int l = 0; l < nl; ++l) conv_layer(a, l, -1, gtid, nthr, -1); }
    { bf16* pt = (bf16*)(ws + WS_POOLT); const float* pw = a.in[12];
      for (int i = bid * NT + tid; i < DEPTH * 4 * 64 * 64; i += G * NT) { const int c = i & 63, d = (i >> 6) & 63, lg = i >> 12; pt[i] = (bf16)f2bf(pw[(size_t)lg * 4096 + c * 64 + d]); }
      bf16* wsb = (bf16*)(ws + WS_WSB); const float* w = a.in[16];
      for (int i = bid * NT + tid; i < DEPTH * 4 * 128 * 128; i += G * NT) { const int s = i & 127, t = (i >> 7) & 127; wsb[i] = (s <= t) ? (bf16)f2bf(w[i]) : (bf16)0; } }
}

#ifndef MIX_A
#define MIX_A 1
#define MIX_B 1
#define MIX_C 1
#define MIX_D 1
#endif
__device__ __forceinline__ void mixer_chunk(const Args& a, LAS unsigned char* lds, int l, int ch, int rowbase, int tid_in, int wave, int lane_in) {
    int tid = tid_in; asm volatile("" : "+v"(tid));
    const int lane = tid & 63; (void)lane_in;
    unsigned char* ws = a.ws;
    const bf16* P = (const bf16*)(ws + WS_P) - (size_t)rowbase * DIN; bf16* MIX = (bf16*)(ws + WS_MIX) - (size_t)rowbase * D;
    const int row0 = ch * CHUNK, pos0 = row0 % SEQ, fr = lane & 15, fq = lane >> 4;
#if MIX_A
    {
#pragma unroll 5
        for (int it = 0; it < 10; ++it) { const int i = it * 16 + (tid >> 5), c8 = (tid & 31) * 8;
            if (i < 158) { u32x4 o = (u32x4){0u, 0u, 0u, 0u};
                if (pos0 + i - 30 >= 0) { const bf16* pr = P + (size_t)(row0 + i - 30) * DIN; const u32x4 v = *(const u32x4*)(pr + c8), g = *(const u32x4*)(pr + 256 + c8);
#pragma unroll
                    for (int e = 0; e < 4; ++e) o[e] = pk2(bf_lo(v[e]) * pg8::fast_sigmoid(bf_lo(g[e])), bf_hi(v[e]) * pg8::fast_sigmoid(bf_hi(g[e]))); }
                *(LAS u32x4*)(lds + i * 512 + c8 * 2) = o; } }
        __syncthreads();
        const float* cw = a.in[7] + (size_t)l * 31 * 256 + 4 * lane;
        f32x4 w[31];
#pragma unroll
        for (int k = 0; k < 31; ++k) w[k] = *(const f32x4*)(cw + k * 256);
        const f32x4 cb = *(const f32x4*)(a.in[8] + l * 256 + 4 * lane), lg = *(const f32x4*)(a.in[9] + l * 256 + 4 * lane), lb = *(const f32x4*)(a.in[10] + l * 256 + 4 * lane);
#pragma unroll 1
        for (int half = 0; half < 2; ++half) { const int jb = 16 * wave + 8 * half;
            f32x4 acc[8];
#pragma unroll
            for (int j = 0; j < 8; ++j) acc[j] = cb;
#pragma unroll
            for (int ii = 0; ii < 38; ++ii) { const u32x2 raw = *(const LAS u32x2*)(lds + (jb + ii) * 512 + lane * 8);
                const f32x4 y = (f32x4){bf_lo(raw.x), bf_hi(raw.x), bf_lo(raw.y), bf_hi(raw.y)};
#pragma unroll
                for (int j = 0; j < 8; ++j) { const int k = ii - j; if (k >= 0 && k <= 30) acc[j] += w[k] * y; }
                if ((ii & 3) == 3) __builtin_amdgcn_sched_barrier(0); }
#pragma unroll
            for (int j = 0; j < 8; ++j) { const float mean = wave_sum((acc[j].x + acc[j].y) + (acc[j].z + acc[j].w)) * (1.0f / 256.0f);
                const f32x4 d = acc[j] - mean; const float var = wave_sum((d.x * d.x + d.y * d.y) + (d.z * d.z + d.w * d.w)) * (1.0f / 256.0f);
                const float rstd = __builtin_amdgcn_rsqf(var + 1e-6f); const f32x4 o = d * rstd * lg + lb;
                u32x2 pk; pk.x = pk2(pg8::fast_silu(o.x), pg8::fast_silu(o.y)); pk.y = pk2(pg8::fast_silu(o.z), pg8::fast_silu(o.w));
                *(u32x2*)(MIX + (size_t)(row0 + jb + j) * D + 4 * lane) = pk; } }
    }
#endif

#if MIX_B
    {
        const float* sw = a.in[11] + (size_t)l * 3 * 256; const int c8 = (tid & 31) * 8, tl0 = (tid >> 5) * 8;
        f32x4 w0[2], w1[2], w2[2];
#pragma unroll
        for (int hh = 0; hh < 2; ++hh) { w0[hh] = *(const f32x4*)(sw + c8 + 4 * hh); w1[hh] = *(const f32x4*)(sw + 256 + c8 + 4 * hh); w2[hh] = *(const f32x4*)(sw + 512 + c8 + 4 * hh); }
        const bf16* pr0 = P + (size_t)(row0 + tl0) * DIN + c8;
        u32x4 scv[10], sxv[10], sbv[8];
#pragma unroll
        for (int r = 0; r < 10; ++r) { if (pos0 + tl0 + r - 2 >= 0) { scv[r] = *(const u32x4*)(pr0 + (ptrdiff_t)(r - 2) * DIN + 768); sxv[r] = *(const u32x4*)(pr0 + (ptrdiff_t)(r - 2) * DIN + 1024); }
            else { scv[r] = (u32x4){0u, 0u, 0u, 0u}; sxv[r] = (u32x4){0u, 0u, 0u, 0u}; } }
#pragma unroll
        for (int r = 0; r < 8; ++r) sbv[r] = *(const u32x4*)(pr0 + (size_t)r * DIN + 512);
        float za[8], zb[8];
#pragma unroll
        for (int e = 0; e < 4; ++e) { za[2 * e] = bf_lo(scv[0][e]) * bf_lo(sxv[0][e]); za[2 * e + 1] = bf_hi(scv[0][e]) * bf_hi(sxv[0][e]); zb[2 * e] = bf_lo(scv[1][e]) * bf_lo(sxv[1][e]); zb[2 * e + 1] = bf_hi(scv[1][e]) * bf_hi(sxv[1][e]); }
#pragma unroll
        for (int r = 0; r < 8; ++r) { float zc[8], o[8];
#pragma unroll
            for (int e = 0; e < 4; ++e) { zc[2 * e] = bf_lo(scv[r + 2][e]) * bf_lo(sxv[r + 2][e]); zc[2 * e + 1] = bf_hi(scv[r + 2][e]) * bf_hi(sxv[r + 2][e]); }
#pragma unroll
            for (int hh = 0; hh < 2; ++hh)
#pragma unroll
                for (int e = 0; e < 4; ++e) o[4 * hh + e] = w0[hh][e] * za[4 * hh + e] + w1[hh][e] * zb[4 * hh + e] + w2[hh][e] * zc[4 * hh + e];
            u32x4 pk;
#pragma unroll
            for (int e = 0; e < 4; ++e) pk[e] = pk2(bf_lo(sbv[r][e]) * o[2 * e], bf_hi(sbv[r][e]) * o[2 * e + 1]);
            *(u32x4*)(MIX + (size_t)(row0 + tl0 + r) * D + 256 + c8) = pk;
#pragma unroll
            for (int e = 0; e < 8; ++e) { za[e] = zb[e]; zb[e] = zc[e]; } }
    }
#endif

    __syncthreads();
#if MIX_C
    {
        constexpr int PITCH = 528;
#pragma unroll 9
        for (int it = 0; it < 9; ++it) { const int idx = it * NT + tid;
            if (idx < 143 * 32) { const int i = idx >> 5, c8 = (idx & 31) * 8; u32x4 v = (u32x4){0u, 0u, 0u, 0u};
                if (pos0 + i - 15 >= 0) v = *(const u32x4*)(P + (size_t)(row0 + i - 15) * DIN + 1280 + c8);
                *(LAS u32x4*)(lds + i * PITCH + c8 * 2) = v; } }
        __syncthreads();
        const int tl = 16 * wave + fr, pos = pos0 + tl, i0 = tl + 15;
        const bf16* poolT = (const bf16*)(ws + WS_POOLT) + (size_t)l * 4 * 4096; const float* pscale = a.in[13] + l * 256;
#pragma unroll 1
        for (int g = 0; g < 4; ++g) { const int wlen = 2 << g;
            f32x4 acc[4];
#pragma unroll
            for (int nb = 0; nb < 4; ++nb) acc[nb] = (f32x4){0.f, 0.f, 0.f, 0.f};
            const float inv = 1.0f / (float)((pos + 1) < wlen ? (pos + 1) : wlen);
#pragma unroll 1
            for (int kk = 0; kk < 2; ++kk) { const int cbase = 64 * g + 32 * kk + 8 * fq;
                float s[8], cur[8];
                { const u32x4 raw = *(const LAS u32x4*)(lds + i0 * PITCH + cbase * 2);
#pragma unroll
                  for (int e = 0; e < 4; ++e) { cur[2 * e] = bf_lo(raw[e]); cur[2 * e + 1] = bf_hi(raw[e]); s[2 * e] = cur[2 * e]; s[2 * e + 1] = cur[2 * e + 1]; } }
#pragma unroll 2
                for (int jj = 1; jj < wlen; ++jj) { const u32x4 raw = *(const LAS u32x4*)(lds + (i0 - jj) * PITCH + cbase * 2);
#pragma unroll
                    for (int e = 0; e < 4; ++e) { s[2 * e] += bf_lo(raw[e]); s[2 * e + 1] += bf_hi(raw[e]); } }
                u32x4 yp;
#pragma unroll
                for (int e = 0; e < 4; ++e) yp[e] = pk2(s[2 * e] * inv - cur[2 * e], s[2 * e + 1] * inv - cur[2 * e + 1]);
                const bf16x8 Y = __builtin_bit_cast(bf16x8, yp);
#pragma unroll
                for (int nb = 0; nb < 4; ++nb) { const bf16x8 X = *(const bf16x8*)(poolT + (size_t)(g * 64 + 16 * nb + fr) * 64 + 32 * kk + 8 * fq);
                    acc[nb] = __builtin_amdgcn_mfma_f32_16x16x32_bf16(X, Y, acc[nb], 0, 0, 0); } }
#pragma unroll
            for (int nb = 0; nb < 4; ++nb) { const int col = 64 * g + 16 * nb + 4 * fq; const f32x4 sc = *(const f32x4*)(pscale + col); const f32x4 o = acc[nb] * sc;
                u32x2 pk; pk.x = pk2(o.x, o.y); pk.y = pk2(o.z, o.w);
                *(u32x2*)(MIX + (size_t)(row0 + tl) * D + 512 + col) = pk; } }
    }
#endif

    __syncthreads();
#if MIX_D
    {
        constexpr int VP = 272;
        const float* lg = a.in[14] + l * 256; const float* lb = a.in[15] + l * 256;
        float gg[4], bb[4];
#pragma unroll
        for (int j = 0; j < 4; ++j) { gg[j] = lg[lane + 64 * j]; bb[j] = lb[lane + 64 * j]; }
#pragma unroll 8
        for (int tt = 0; tt < 16; ++tt) { const int tl = 16 * wave + tt; const bf16* pr = P + (size_t)(row0 + tl) * DIN + 1792;
            float x[4];
#pragma unroll
            for (int j = 0; j < 4; ++j) x[j] = __uint_as_float(((unsigned)pr[lane + 64 * j]) << 16);
            const float mean = wave_sum((x[0] + x[1]) + (x[2] + x[3])) * (1.0f / 256.0f);
#pragma unroll
            for (int j = 0; j < 4; ++j) x[j] -= mean;
            const float var = wave_sum((x[0] * x[0] + x[1] * x[1]) + (x[2] * x[2] + x[3] * x[3])) * (1.0f / 256.0f);
            const float rstd = __builtin_amdgcn_rsqf(var + 1e-6f);
#pragma unroll
            for (int j = 0; j < 4; ++j) *(LAS bf16*)(lds + (lane + 64 * j) * VP + tl * 2) = (bf16)f2bf(x[j] * rstd * gg[j] + bb[j]); }
        __syncthreads();
        const bf16* wsb = (const bf16*)(ws + WS_WSB) + (size_t)l * 4 * 128 * 128; const float* bs = a.in[17] + (size_t)l * 4 * 128;
        const int t = 16 * wave + fr; const bf16* pu = P + (size_t)(row0 + t) * DIN + 1536; bf16* po = MIX + (size_t)(row0 + t) * D + 768;
#pragma unroll 1
        for (int h = 0; h < 4; ++h) { bf16x8 Y[4];
#pragma unroll
            for (int kk = 0; kk < 4; ++kk) Y[kk] = *(const bf16x8*)(wsb + ((size_t)(h * 128 + t)) * 128 + 32 * kk + 8 * fq);
            const float bias = bs[h * 128 + t];
#pragma unroll
            for (int cb = 0; cb < 4; ++cb) { f32x4 acc = (f32x4){0.f, 0.f, 0.f, 0.f};
#pragma unroll
                for (int kk = 0; kk < 4; ++kk) if (kk <= (wave >> 1)) { const bf16x8 X = *(const LAS bf16x8*)(lds + (64 * h + 16 * cb + fr) * VP + (32 * kk + 8 * fq) * 2);
                    acc = __builtin_amdgcn_mfma_f32_16x16x32_bf16(X, Y[kk], acc, 0, 0, 0); }
                const int c = 64 * h + 16 * cb + 4 * fq; const u32x2 gu = *(const u32x2*)(pu + c);
                u32x2 pk; pk.x = pk2(bf_lo(gu.x) * (acc.x + bias), bf_hi(gu.x) * (acc.y + bias)); pk.y = pk2(bf_lo(gu.y) * (acc.z + bias), bf_hi(gu.y) * (acc.w + bias));
                *(u32x2*)(po + c) = pk; } }
    }
#endif

    __syncthreads();
}

typedef GAS unsigned gu32;
#define XB_TMO      128
#define XB_XCNT(j)  (256  + 64 * (j))
#define XB_XSUB(j)  (1280 + 64 * (j))
#define XB_XGEN(j)  (2304 + 64 * (j))
#define XB_TOP      3328
#define XB_TOPGEN   3392
#define XCD_BAR_WORDS 3456
#define XB_SPIN_CAP (1u << 18)

__device__ __forceinline__ unsigned xb_ld(unsigned* p)              { return __hip_atomic_load(p, __ATOMIC_RELAXED, __HIP_MEMORY_SCOPE_AGENT); }
__device__ __forceinline__ unsigned xb_add(unsigned* p, unsigned v) { return __hip_atomic_fetch_add(p, v, __ATOMIC_RELAXED, __HIP_MEMORY_SCOPE_AGENT); }
__device__ __forceinline__ unsigned xb_xcc_id() { return (unsigned)__builtin_amdgcn_s_getreg((3 << 11) | 20) & 0xFu; }
#define XB_SPIN(cond, bar) do { unsigned _sp = 0; while (cond) { __builtin_amdgcn_s_sleep(1); \
    if ((++_sp & 255u) == 0u) { if (xb_ld(&(bar)[XB_TMO])) break; if (_sp > XB_SPIN_CAP) { atomicAdd(&(bar)[XB_TMO], 1u); break; } } } } while (0)

struct XcdBarrier {
    unsigned* bar; unsigned x;
    volatile LAS unsigned* st;
};

__device__ __forceinline__ XcdBarrier xcd_barrier_post(unsigned* bar, volatile LAS unsigned* st) {
    XcdBarrier b; b.bar = bar; b.x = xb_xcc_id(); b.st = st;
    if (threadIdx.x == 0) (void)xb_add(&bar[XB_XCNT(b.x)], 1u);
    return b;
}
__device__ __forceinline__ void xcd_barrier_complete(unsigned* bar, unsigned x, unsigned& nloc, unsigned& nx) {
    const unsigned G = gridDim.x * gridDim.y * gridDim.z;
    unsigned sum, cnt, mine, sp = 0u;
    for (;;) {
        sum = 0u; cnt = 0u; mine = 0u;
#pragma unroll
        for (unsigned j = 0; j < 16; ++j) { const unsigned c = xb_ld(&bar[XB_XCNT(j)]); sum += c; cnt += (c > 0u) ? 1u : 0u; mine = (j == x) ? c : mine; }
        if (sum == G) break;
        __builtin_amdgcn_s_sleep(1);
        if ((++sp & 255u) == 0u) { if (xb_ld(&bar[XB_TMO])) break; if (sp > XB_SPIN_CAP) { atomicAdd(&bar[XB_TMO], 1u); break; } }
    }
    nloc = mine > 0u ? mine : 1u; nx = cnt > 0u ? cnt : 1u;
}

__device__ __forceinline__ void xcd_barrier(const XcdBarrier& b) {
    asm volatile("s_waitcnt vmcnt(0)" ::: "memory");
    __syncthreads();
    if (threadIdx.x == 0) {
        unsigned* bar = b.bar;
        __builtin_amdgcn_s_waitcnt(0);
        unsigned nloc = b.st[0], nx = b.st[1];
        if (nloc == 0u) { xcd_barrier_complete(bar, b.x, nloc, nx); b.st[0] = nloc; b.st[1] = nx; }
        const unsigned old = xb_add(&bar[XB_XSUB(b.x)], 1u);
        const unsigned gen = old / nloc;
        if (old + 1u == (gen + 1u) * nloc) {
            __builtin_amdgcn_fence(__ATOMIC_RELEASE, "agent");
            asm volatile("s_waitcnt vmcnt(0)" ::: "memory");
            const unsigned og = xb_add(&bar[XB_TOP], 1u);
            const unsigned tg = og / nx;
            if (og + 1u == (tg + 1u) * nx) xb_add(&bar[XB_TOPGEN], 1u);
            else XB_SPIN(xb_ld(&bar[XB_TOPGEN]) == tg, bar);
            __builtin_amdgcn_fence(__ATOMIC_ACQUIRE, "agent");
            xb_add(&bar[XB_XGEN(b.x)], 1u);
            asm volatile("s_waitcnt vmcnt(0)" ::: "memory");
        } else {
            XB_SPIN(xb_ld(&bar[XB_XGEN(b.x)]) == gen, bar);
            __builtin_amdgcn_fence(__ATOMIC_ACQUIRE, "agent");
            asm volatile("s_waitcnt vmcnt(0)" ::: "memory");
        }
    }
    __syncthreads();
}

#define GB_MASK(g) (4096 + 64 * (g))
#define GB_CNT(g)  (4096 + 512 + 64 * (g))
#define GB_GEN(g)  (4096 + 1024 + 64 * (g))
#define CTL_WORDS  6144
__device__ __noinline__ void group_barrier(unsigned* bar, unsigned g, unsigned nmem) {
    asm volatile("s_waitcnt vmcnt(0)" ::: "memory");
    __syncthreads();
    if (threadIdx.x == 0) {
        const unsigned old = xb_add(&bar[GB_CNT(g)], 1u), gen = old / nmem;
        if (old + 1u == (gen + 1u) * nmem) xb_add(&bar[GB_GEN(g)], 1u);
        else XB_SPIN(xb_ld(&bar[GB_GEN(g)]) == gen, bar);
        __builtin_amdgcn_fence(__ATOMIC_ACQUIRE, "agent");
        asm volatile("s_waitcnt vmcnt(0)" ::: "memory");
    }
    __syncthreads();
}
#ifndef PROBE_ZERO
#define PROBE_ZERO 0
#endif
#ifndef PROBE_MIX2
#define PROBE_G1 0
#define PROBE_G2 0
#define PROBE_G3 0
#define PROBE_G4 0
#define PROBE_MIX2 0
#define PROBE_PRO2 0
#define PROBE_SYNC2 0
#endif
#define GRID_SYNC_CG() do { asm volatile("s_waitcnt vmcnt(0)" ::: "memory"); grid.sync(); } while (0)
#define GRID_SYNC() xcd_barrier(xbar)
__global__ void __launch_bounds__(NT, 2) mk_fwd(Args a) {
    extern __shared__ __attribute__((aligned(16))) unsigned char lds_raw[];
    LAS unsigned char* lds = (LAS unsigned char*)lds_raw;
    cg::grid_group grid = cg::this_grid();
    const int tid0 = threadIdx.x, wave = __builtin_amdgcn_readfirstlane(tid0 >> 6), G = gridDim.x, bid = blockIdx.x;
    unsigned char* ws = a.ws;
    unsigned long long* ssb = (unsigned long long*)(ws + WS_SS); bf16* xb = (bf16*)(ws + WS_XB); bf16* U = (bf16*)(ws + WS_R); bf16* Pb = (bf16*)(ws + WS_P); bf16* MIXb = (bf16*)(ws + WS_MIX);
    float* xf = a.out;
    volatile LAS unsigned* xb_st = (volatile LAS unsigned*)(lds + 131072 + 64);
    if (tid0 < 3) xb_st[tid0] = 0u;
    if (bid == 0) for (int i = tid0; i < CTL_WORDS; i += NT) ((unsigned*)(ws + WS_CTL))[i] = 0u;
    __syncthreads();
    XcdBarrier xbar; xbar.bar = (unsigned*)(ws + WS_CTL); xbar.x = 0; xbar.st = xb_st;

    for (int pp = a.ph_lo; pp < a.ph_hi; ++pp) {
        int tid = tid0; asm volatile("" : "+v"(tid)); const int lane = tid & 63;
        if (pp == 0) { prologue(a, lds, G, bid, tid, wave, lane);
#if PROBE_PRO2
            __syncthreads(); prologue(a, lds, G, bid, tid, wave, lane);
#endif
        }
        else if (pp == NPHASE - 1) {
            const unsigned long long* ss = ssb + (size_t)12 * M; const float* gain = a.in[23]; const int gw = bid * NWAVES + wave, NGW = G * NWAVES;
            f32x4 gv[4];
#pragma unroll
            for (int j = 0; j < 4; ++j) gv[j] = *((const f32x4*)gain + lane + 64 * j);
            for (int m = gw; m < M; m += NGW) { f32x4* orow = (f32x4*)(xf + (size_t)m * D) + lane; const u32x2* xr = (const u32x2*)(xb + (size_t)m * D) + lane; const float r = pg8::ss_rnorm(ss[m]);
#pragma unroll
                for (int j = 0; j < 4; ++j) { const u32x2 v = xr[64 * j]; orow[64 * j] = (f32x4){bf_lo(v.x), bf_hi(v.x), bf_lo(v.y), bf_hi(v.y)} * r * gv[j]; } }
        } else {
        const int ph = pp - 1;
        const int hb = ph / (7 * DEPTH), l = (ph / 7) % DEPTH, st = ph % 7; const unsigned char* wl = ws + WS_W + (size_t)l * W_LAYER;
        const size_t r0 = (size_t)hb * MH; bf16* xbh = xb + r0 * D;
        if (st == 0 || st == 5) {
            const int si = 3 * l + (st == 0 ? 0 : 2);
            pg8::Gemm g{xbh, (const bf16*)(wl + (st == 0 ? WO_13A : WO_13B)), MH, 2 * FF, D}; pg8::StaticOrder S; S.init(MH, 2 * FF, G, bid);
            pg8::EpiSwiglu E{U, ssb + (size_t)si * M + r0, 0};
#if PROBE_ZERO
            if (ph == 0) { pg8::Gemm gz = g; pg8::EpiSwiglu Ez = E; Ez.cheap = 1; gz.pm_mask = 3; gz.pn_mask = 3;
#if PROBE_ZERO == 1
                gz.A = (const bf16*)(ws + WS_SS + (size_t)M * 8); gz.Bt = (const bf16*)(ws + WS_SS + (size_t)M * 8 + 2 * MiB);
#endif
                pg8::gemm_phase<pg8::EpiSwiglu, pg8::StaticOrder, true, true>(lds, gz, S, Ez); GRID_SYNC(); }
#endif
            for (int rep_ = 0; rep_ < 1 + (PROBE_G1 ? 1 : 0); ++rep_) { if (rep_) GRID_SYNC(); E.cheap = (PROBE_G1 >= 2 && rep_ == 0) ? 1 : 0; g.pm_mask = (PROBE_G1 == 3 && rep_ == 0) ? 0 : -1; g.pn_mask = (PROBE_G1 == 4 && rep_ == 0) ? 0 : ((PROBE_G1 == 3 && rep_ == 0) ? 3 : -1);
            pg8::gemm_phase<pg8::EpiSwiglu, pg8::StaticOrder, true, true>(lds, g, S, E); }
        } else if (st == 1 || st == 4 || st == 6) {
            const int so = 3 * l + (st == 1 ? 1 : (st == 4 ? 2 : 3));
            pg8::Gemm g{st == 4 ? MIXb : U, (const bf16*)(wl + (st == 1 ? WO_2A : (st == 4 ? WO_OUT : WO_2B))), MH, D, st == 4 ? D : FF}; pg8::StaticOrder S; S.init(MH, D, G, bid);
            pg8::EpiResid E{xbh, ssb + (size_t)so * M + r0, st == 4 ? 1.0f : 0.5f, 0};
            const int nrep = 1 + ((st == 4) ? PROBE_G4 : PROBE_G2);
            const bool shift = false; const int setB = (bid >> 3) & 1, srank = (bid & 7) + 8 * (bid >> 4);
            if (shift && setB) conv_layer(a, l + 1, st == 1 ? 0 : 1, srank * NT + tid, (G / 2) * NT, 0);
            for (int rep_ = 0; rep_ < nrep; ++rep_) { if (rep_) GRID_SYNC(); E.dry = (rep_ + 1 < nrep) ? 1 : 0;
            pg8::gemm_phase<pg8::EpiResid, pg8::StaticOrder, true, true>(lds, g, S, E); }
            if (shift && !setB) conv_layer(a, l + 1, st == 1 ? 0 : 1, srank * NT + tid, (G / 2) * NT, 1);
        } else if (st == 2) {
            pg8::Gemm g{xbh, (const bf16*)(wl + WO_IN), MH, DIN, D}; pg8::StaticOrder S; S.init(MH, DIN, G, bid); S.wgm = 8;
            pg8::EpiScale E{Pb, DIN, ssb + (size_t)(3 * l + 1) * M + r0};
            for (int rep_ = 0; rep_ < 1 + PROBE_G3; ++rep_) { if (rep_) GRID_SYNC();
            pg8::gemm_phase<pg8::EpiScale, pg8::StaticOrder, true, true>(lds, g, S, E); }
        } else {
            for (int rep_ = 0; rep_ < 1 + PROBE_MIX2; ++rep_)
            for (int c0 = bid; c0 < NCHUNK / NSPLIT; c0 += G) { const int ch = (G == 256 && NCHUNK / NSPLIT == 256) ? 32 * (c0 & 7) + (c0 >> 3) : c0;
                mixer_chunk(a, lds, l, hb * (NCHUNK / NSPLIT) + ch, (int)r0, tid, wave, lane); }
        }
        }
        if (pp + 1 < a.ph_hi) {
            if (pp == 0) { GRID_SYNC_CG(); xbar = xcd_barrier_post((unsigned*)(ws + WS_CTL), xb_st);
                if (tid0 == 0) atomicOr((unsigned*)(ws + WS_CTL) + GB_MASK(bid & 7), 1u << xbar.x); }
            else if (pp == 1) { GRID_SYNC();
                if (tid0 == 0) { bool one = (G == 256 && NCHUNK / NSPLIT == 256);
                    for (int g_ = 0; g_ < 8; ++g_) one = one && __builtin_popcount(xb_ld((unsigned*)(ws + WS_CTL) + GB_MASK(g_))) == 1;
                    xb_st[2] = one ? 1u : 0u; }
                __syncthreads(); }
            else { const int st_ = (pp - 1) % 7; const bool light = __builtin_amdgcn_readfirstlane((int)xb_st[2]) != 0 && (st_ == 0 || st_ == 3 || st_ == 5 || st_ == 6) && pp + 2 < NPHASE;
                if (light) group_barrier((unsigned*)(ws + WS_CTL), (unsigned)(bid & 7), (unsigned)(G / 8)); else GRID_SYNC(); }
#if PROBE_SYNC2
            GRID_SYNC();
#endif
        }
    }
}

extern "C" void kernel_launch(void* const* d_in, const int* in_sizes, int n_in, void* d_out, int out_size, void* d_ws, size_t ws_size, hipStream_t stream) {
    static int grid = 0;
    if (grid == 0) {
        if (n_in != 24 || out_size != M * D || ws_size < WS_END) { fprintf(stderr, "kernel_launch: unexpected shapes (n_in %d out %d ws %zu)\n", n_in, out_size, ws_size); grid = -1; return; }
        int dev = 0, cus = 0, per_cu = 0;
        hipGetDevice(&dev); hipDeviceGetAttribute(&cus, hipDeviceAttributeMultiprocessorCount, dev);
        if (hipFuncSetAttribute((const void*)mk_fwd, hipFuncAttributeMaxDynamicSharedMemorySize, LDS_BYTES) != hipSuccess) { fprintf(stderr, "kernel_launch: hipFuncSetAttribute failed\n"); grid = -1; return; }
        if (hipOccupancyMaxActiveBlocksPerMultiprocessor(&per_cu, (const void*)mk_fwd, NT, LDS_BYTES) != hipSuccess || per_cu < 1) { fprintf(stderr, "kernel_launch: occupancy query gave %d\n", per_cu); per_cu = 1; }
        (void)hipGetLastError();
        grid = cus * per_cu;
    }
    if (grid < 0) return;
    Args a{};
    for (int i = 0; i < 24; ++i) a.in[i] = (const float*)d_in[i];
    a.out = (float*)d_out; a.ws = (unsigned char*)d_ws;
#ifndef MK_PER_PHASE
#define MK_PER_PHASE 0
#endif
#if MK_PER_PHASE
    for (int p = 0; p < DEPTH * 7 + 2; ++p) { a.ph_lo = p; a.ph_hi = p + 1; hipLaunchKernelGGL(mk_fwd, dim3(grid), dim3(NT), LDS_BYTES, stream, a); }
#else
    a.ph_lo = 0; a.ph_hi = NPHASE;
    void* args[] = {&a};
    hipError_t e = hipLaunchCooperativeKernel((const void*)mk_fwd, dim3(grid), dim3(NT), args, LDS_BYTES, stream);
    if (e != hipSuccess) fprintf(stderr, "cooperative launch failed: %s (grid %d)\n", hipGetErrorString(e), grid);
#endif
}
```

```cpp
#include <hip/hip_runtime.h>
#include <hip/hip_cooperative_groups.h>
#include <cstdio>
#include <cstdint>
namespace pg8 {
#define PG8_LAS __attribute__((address_space(3)))
typedef unsigned short bf16_t;
typedef short bf16x8 __attribute__((ext_vector_type(8)));
typedef float f32x4 __attribute__((ext_vector_type(4)));
typedef unsigned u32x4 __attribute__((ext_vector_type(4)));
constexpr int BM = 256, BK = 64, HALF = 128, HTB = HALF * BK * 2  , STAGE_BYTES = 8 * HTB, NXCD = 8, WGM = 4;

__host__ __device__ __forceinline__ int lds_byte(int r, int c) { const int st = (r >> 4) * 2 + (c >> 5), rr = r & 15, cc = c & 31, ob = rr * 64 + cc * 2; return st * 1024 + (ob ^ (((ob >> 9) & 1) << 5)); }
__host__ __device__ __forceinline__ void stage_rc(int b, int& R, int& C) { const int st = b / 1024, sb = b % 1024, swz = sb ^ (((sb >> 9) & 1) << 5); R = (st >> 1) * 16 + swz / 64; C = (st & 1) * 32 + (swz % 64) / 2; }
__host__ __device__ __forceinline__ int perm32(int rho) { const int n = rho >> 4, i = rho & 15; return 8 * (i >> 2) + 4 * n + (i & 3); }

struct Unit { int pm, pn; };
struct Gemm { const bf16_t* A; const bf16_t* Bt; int M, N, K; int pm_mask = -1, pn_mask = -1; };

struct StaticOrder {
    int nM, nN, nwg, G, c;
    __host__ __device__ void init(int M, int N, int G_, int c_) { nM = M / BM; nN = N / BM; nwg = nM * nN; G = G_; c = c_; }
    __host__ __device__ bool next(int i, Unit& u) const {
        const long L = (long)i * G + c; if (L >= nwg) return false;
        int wgid = (int)L; { const int q = nwg / NXCD, r = nwg % NXCD, xcd = wgid % NXCD, off = wgid / NXCD; wgid = (xcd < r ? xcd * (q + 1) : r * (q + 1) + (xcd - r) * q) + off; }
        const int nig = WGM * nN, gid = wgid / nig, fm = gid * WGM, gsz = (nM - fm) < WGM ? (nM - fm) : WGM;
        u.pm = fm + ((wgid % nig) % gsz); u.pn = (wgid % nig) / gsz; return true;
    }
    __device__ __forceinline__ void a_ready(const Unit&) const {}
    __device__ __forceinline__ void done(const Unit&) const {}
};
__device__ __forceinline__ unsigned cvt_pk_bf16(float lo, float hi) { unsigned r; asm("v_cvt_pk_bf16_f32 %0, %1, %2" : "=v"(r) : "v"(lo), "v"(hi)); return r; }
typedef float f32x2 __attribute__((ext_vector_type(2)));
typedef unsigned u32x2 __attribute__((ext_vector_type(2)));
constexpr float RMS_EPS = 1e-6f;
__device__ __forceinline__ unsigned long long ss_fix(float q) { return (unsigned long long)(q * 1048576.0f + 0.5f); }
__device__ __forceinline__ float ss_rnorm(unsigned long long s) { return __builtin_amdgcn_rsqf((float)s * (1.0f / (1048576.0f * 1024.0f)) + RMS_EPS); }
__device__ __forceinline__ float fast_sigmoid(float g) { return __builtin_amdgcn_rcpf(1.0f + __builtin_amdgcn_exp2f(-1.4426950408889634f * g)); }
__device__ __forceinline__ float fast_silu(float a) { return a * fast_sigmoid(a); }

struct EpiSwiglu {
    static constexpr bool PERM = true, AFTER_DRAIN = false;
    bf16_t* U; const unsigned long long* ss; int cheap;
    __device__ __forceinline__ void operator()(const f32x4 (&acc)[2][2][4][2], const Unit& u, int wr, int wc, int fr, int fq) const {
        const int row0 = u.pm * BM + wr * 64 + fr, col0 = u.pn * HALF + wc * 32 + 8 * fq;
#pragma unroll
        for (int ai = 0; ai < 2; ++ai)
#pragma unroll
            for (int m = 0; m < 4; ++m) { const int row = row0 + ai * HALF + m * 16;
                float o[8];
                if (cheap) {
#pragma unroll
                    for (int n = 0; n < 2; ++n)
#pragma unroll
                        for (int j = 0; j < 4; ++j) o[4 * n + j] = acc[ai][0][m][n][j] + acc[ai][1][m][n][j];
                } else {
                const float r = ss_rnorm(ss[row]), r2 = r * -1.4426950408889634f;
                float av[8], bv[8], tv[8];
#pragma unroll
                for (int n = 0; n < 2; ++n)
#pragma unroll
                    for (int j = 0; j < 4; ++j) { av[4 * n + j] = acc[ai][0][m][n][j] * r; bv[4 * n + j] = acc[ai][1][m][n][j] * r; tv[4 * n + j] = acc[ai][0][m][n][j] * r2; }
#pragma unroll
                for (int i = 0; i < 8; ++i) tv[i] = __builtin_amdgcn_exp2f(tv[i]);
#pragma unroll
                for (int i = 0; i < 8; ++i) tv[i] = __builtin_amdgcn_rcpf(1.0f + tv[i]);
#pragma unroll
                for (int i = 0; i < 8; ++i) o[i] = (av[i] * tv[i]) * bv[i]; }
                u32x4 w; w.x = cvt_pk_bf16(o[0], o[1]); w.y = cvt_pk_bf16(o[2], o[3]); w.z = cvt_pk_bf16(o[4], o[5]); w.w = cvt_pk_bf16(o[6], o[7]);
                *(u32x4*)(U + (size_t)row * 2816 + col0) = w; }
    }
};
struct EpiScale {
    static constexpr bool PERM = true, AFTER_DRAIN = false;
    bf16_t* O; int ldc; const unsigned long long* ss;
    __device__ __forceinline__ void operator()(const f32x4 (&acc)[2][2][4][2], const Unit& u, int wr, int wc, int fr, int fq) const {
        const int row0 = u.pm * BM + wr * 64 + fr, col0 = u.pn * BM + wc * 32 + 8 * fq;
#pragma unroll
        for (int ai = 0; ai < 2; ++ai)
#pragma unroll
            for (int m = 0; m < 4; ++m) { const int row = row0 + ai * HALF + m * 16;
                const float r = ss_rnorm(ss[row]);
                bf16_t* rowp = O + (size_t)row * ldc + col0;
#pragma unroll
                for (int bj = 0; bj < 2; ++bj) { const f32x4 v0 = acc[ai][bj][m][0] * r, v1 = acc[ai][bj][m][1] * r;
                    u32x4 w; w.x = cvt_pk_bf16(v0[0], v0[1]); w.y = cvt_pk_bf16(v0[2], v0[3]); w.z = cvt_pk_bf16(v1[0], v1[1]); w.w = cvt_pk_bf16(v1[2], v1[3]);
                    *(u32x4*)(rowp + bj * HALF) = w; } }
    }
};
struct EpiResid {
    static constexpr bool PERM = true, AFTER_DRAIN = false;
    bf16_t* xb; unsigned long long* ssout; float scale; int dry;
    __device__ __forceinline__ void operator()(const f32x4 (&acc)[2][2][4][2], const Unit& u, int wr, int wc, int fr, int fq) const {
        const int row0 = u.pm * BM + wr * 64 + fr, col0 = u.pn * BM + wc * 32 + 8 * fq; const float scale = dry ? 0.f : this->scale;
        u32x4 xr[2][4][2];
#pragma unroll
        for (int ai = 0; ai < 2; ++ai)
#pragma unroll
            for (int m = 0; m < 4; ++m)
#pragma unroll
                for (int bj = 0; bj < 2; ++bj) xr[ai][m][bj] = *(const u32x4*)(xb + (size_t)(row0 + ai * HALF + m * 16) * 1024 + col0 + bj * HALF);
#pragma unroll
        for (int ai = 0; ai < 2; ++ai)
#pragma unroll
            for (int m = 0; m < 4; ++m) { const int row = row0 + ai * HALF + m * 16; const size_t off = (size_t)row * 1024 + col0;
                float q = 0.f;
#pragma unroll
                for (int bj = 0; bj < 2; ++bj) {
                    const u32x4 xv = xr[ai][m][bj];
                    const f32x4 x0 = (f32x4){__uint_as_float(xv.x << 16), __uint_as_float(xv.x & 0xffff0000u), __uint_as_float(xv.y << 16), __uint_as_float(xv.y & 0xffff0000u)};
                    const f32x4 x1 = (f32x4){__uint_as_float(xv.z << 16), __uint_as_float(xv.z & 0xffff0000u), __uint_as_float(xv.w << 16), __uint_as_float(xv.w & 0xffff0000u)};
                    const f32x4 y0 = x0 + acc[ai][bj][m][0] * scale, y1 = x1 + acc[ai][bj][m][1] * scale;
                    u32x4 w; w.x = cvt_pk_bf16(y0[0], y0[1]); w.y = cvt_pk_bf16(y0[2], y0[3]); w.z = cvt_pk_bf16(y1[0], y1[1]); w.w = cvt_pk_bf16(y1[2], y1[3]);
                    *(u32x4*)(xb + off + bj * HALF) = w;
                    q += (y0[0] * y0[0] + y0[1] * y0[1]) + (y0[2] * y0[2] + y0[3] * y0[3]) + (y1[0] * y1[0] + y1[1] * y1[1]) + (y1[2] * y1[2] + y1[3] * y1[3]); }
                q += __shfl_xor(q, 16); q += __shfl_xor(q, 32);
                if (fq == 0 && !dry) atomicAdd(ssout + row, ss_fix(q)); }
    }
};
template <class Epi, class Sched, bool ALIGN_EPI = false, bool SP2 = false>
__device__ __forceinline__ void gemm_phase(PG8_LAS unsigned char* lds, const Gemm g, const Sched& S, const Epi& E) {
    int tid_l = threadIdx.x; asm volatile("" : "+v"(tid_l));
    const int tid = tid_l, wid = __builtin_amdgcn_readfirstlane(tid >> 6), lane = tid & 63, wr = wid >> 2, wc = wid & 3, fr = lane & 15, fq = lane >> 4;
    const int K = g.K, nt = K / BK;
    unsigned voffA[2], voffB[2];
#pragma unroll
    for (int i = 0; i < 2; ++i) { int R, C; stage_rc(tid * 16 + i * 8192, R, C); const int Rb = Epi::PERM ? ((R & ~31) + perm32(R & 31)) : R;
        voffA[i] = (unsigned)(R * K + C) * 2u; voffB[i] = (unsigned)(Rb * K + C) * 2u; }
    const size_t kstep = (size_t)(BK * 2);
    const size_t hstep = (size_t)HALF * K * 2;
    const size_t tstep = 2 * hstep;
    const unsigned ldsw = (unsigned)wid * 1024u;
    const int aoff = lds_byte(wr * 64 + fr, fq * 8), boff = lds_byte(wc * 32 + fr, fq * 8);
#define PG8_SA(b, h) (((b) * 2 + (h)) * HTB)
#define PG8_SB(b, h) ((4 + (b) * 2 + (h)) * HTB)
#define PG8_STAGE(bufoff, gbase, voff) do { _Pragma("unroll") for (int _i = 0; _i < 2; ++_i) \
        __builtin_amdgcn_global_load_lds((const unsigned*)((const char*)(gbase) + (voff)[_i]), (PG8_LAS unsigned*)(lds + (bufoff) + ldsw + _i * 8192), 16, 0, 0); } while (0)
#define PG8_LDA(dst, b, h) do { _Pragma("unroll") for (int m = 0; m < 4; ++m) _Pragma("unroll") for (int k = 0; k < 2; ++k) dst[m][k] = *(const PG8_LAS bf16x8*)(lds + PG8_SA(b, h) + aoff + m * 2048 + k * 1024); } while (0)
#define PG8_LDB(dst, b, h) do { _Pragma("unroll") for (int n = 0; n < 2; ++n) _Pragma("unroll") for (int k = 0; k < 2; ++k) dst[n][k] = *(const PG8_LAS bf16x8*)(lds + PG8_SB(b, h) + boff + n * 2048 + k * 1024); } while (0)
#define PG8_MMA(ai, bj, At, Bt) do { __builtin_amdgcn_s_setprio(1); _Pragma("unroll") for (int m = 0; m < 4; ++m) _Pragma("unroll") for (int n = 0; n < 2; ++n) _Pragma("unroll") for (int k = 0; k < 2; ++k) \
        acc[ai][bj][m][n] = __builtin_amdgcn_mfma_f32_16x16x32_bf16(Bt[n][k], At[m][k], acc[ai][bj][m][n], 0, 0, 0); __builtin_amdgcn_s_setprio(0); } while (0)
#define PG8_WAIT_V(n) asm volatile("s_waitcnt vmcnt(" #n ")" ::: "memory")
#define PG8_WAIT_L(n) asm volatile("s_waitcnt lgkmcnt(" #n ")" ::: "memory")
#define PG8_BAR __builtin_amdgcn_s_barrier()
#define PG8_SCHED __builtin_amdgcn_sched_barrier(0)
    Unit cur, nxt; int ui = 0;
    if (!S.next(0, cur)) return;
    f32x4 acc[2][2][4][2];
#pragma unroll
    for (int a = 0; a < 2; ++a)
#pragma unroll
        for (int b = 0; b < 2; ++b)
#pragma unroll
            for (int m = 0; m < 4; ++m)
#pragma unroll
                for (int n = 0; n < 2; ++n) acc[a][b][m][n] = (f32x4){0.f, 0.f, 0.f, 0.f};
    bf16x8 At[4][2], B0[2][2], B1[2][2];
    const char* cA = (const char*)g.A + (size_t)(cur.pm & g.pm_mask) * tstep; const char* cB = (const char*)g.Bt + (size_t)(cur.pn & g.pn_mask) * tstep;
    S.a_ready(cur);
    if constexpr (SP2) {
        PG8_STAGE(PG8_SB(0, 0), cB, voffB); PG8_STAGE(PG8_SB(0, 1), cB + hstep, voffB); PG8_STAGE(PG8_SA(0, 0), cA, voffA); PG8_STAGE(PG8_SA(0, 1), cA + hstep, voffA);
        if (wr == 1) PG8_BAR;
        PG8_WAIT_V(2); PG8_BAR;
        PG8_STAGE(PG8_SB(1, 0), cB + kstep, voffB); PG8_STAGE(PG8_SA(1, 0), cA + kstep, voffA); PG8_STAGE(PG8_SB(1, 1), cB + hstep + kstep, voffB);
        PG8_WAIT_V(6); PG8_BAR;
    } else {
        PG8_STAGE(PG8_SB(0, 0), cB, voffB); PG8_STAGE(PG8_SA(0, 0), cA, voffA); PG8_STAGE(PG8_SB(0, 1), cB + hstep, voffB); PG8_STAGE(PG8_SA(0, 1), cA + hstep, voffA);
        if (wr == 1) PG8_BAR;
        PG8_WAIT_V(4); PG8_BAR;
        PG8_STAGE(PG8_SB(1, 0), cB + kstep, voffB); PG8_STAGE(PG8_SA(1, 0), cA + kstep, voffA); PG8_STAGE(PG8_SB(1, 1), cB + hstep + kstep, voffB);
        PG8_WAIT_V(6); PG8_BAR;
    }
    for (;;) {
        const bool has_next = S.next(ui + 1, nxt);
        const char* nA = has_next ? (const char*)g.A + (size_t)(nxt.pm & g.pm_mask) * tstep : cA; const char* nB = has_next ? (const char*)g.Bt + (size_t)(nxt.pn & g.pn_mask) * tstep : cB;
        for (int t = 0; t < nt; t += 2) {
            const bool last = (t == nt - 2);
            const char* a1 = cA + (size_t)(t + 1) * kstep;
            const char* a2 = last ? nA : cA + (size_t)(t + 2) * kstep; const char* b2 = last ? nB : cB + (size_t)(t + 2) * kstep;
            const char* a3 = a2 + kstep; const char* b3 = b2 + kstep;
            if (last && has_next) S.a_ready(nxt);
            if constexpr (SP2) {
            PG8_LDB(B0, 0, 0); PG8_LDB(B1, 0, 1); PG8_SCHED; PG8_LDA(At, 0, 0); PG8_STAGE(PG8_SA(1, 1), a1 + hstep, voffA);
            PG8_WAIT_V(8); PG8_WAIT_L(0); PG8_BAR; PG8_MMA(0, 0, At, B0); PG8_MMA(0, 1, At, B1); PG8_BAR; PG8_SCHED;
            PG8_LDA(At, 0, 1); PG8_STAGE(PG8_SB(0, 0), b2, voffB); PG8_STAGE(PG8_SB(0, 1), b2 + hstep, voffB); PG8_STAGE(PG8_SA(0, 0), a2, voffA);
            PG8_WAIT_V(8); PG8_WAIT_L(0); PG8_BAR; PG8_MMA(1, 0, At, B0); PG8_MMA(1, 1, At, B1); PG8_BAR; PG8_SCHED;
            PG8_LDB(B0, 1, 0); PG8_LDB(B1, 1, 1); PG8_SCHED; PG8_LDA(At, 1, 0); PG8_STAGE(PG8_SA(0, 1), a2 + hstep, voffA);
            PG8_WAIT_V(8); PG8_WAIT_L(0); PG8_BAR; PG8_MMA(0, 0, At, B0); PG8_MMA(0, 1, At, B1); PG8_BAR; PG8_SCHED;
            PG8_LDA(At, 1, 1); PG8_STAGE(PG8_SB(1, 0), b3, voffB); PG8_STAGE(PG8_SB(1, 1), b3 + hstep, voffB); PG8_STAGE(PG8_SA(1, 0), a3, voffA);
            PG8_WAIT_V(8); PG8_WAIT_L(0); PG8_BAR; PG8_MMA(1, 0, At, B0); PG8_MMA(1, 1, At, B1); PG8_BAR; PG8_SCHED;
            } else {
            PG8_LDB(B0, 0, 0); PG8_SCHED; PG8_LDA(At, 0, 0); PG8_STAGE(PG8_SA(1, 1), a1 + hstep, voffA);
            PG8_WAIT_L(8); PG8_BAR; PG8_WAIT_L(0); PG8_MMA(0, 0, At, B0); PG8_BAR; PG8_SCHED;
            PG8_LDB(B1, 0, 1); PG8_STAGE(PG8_SB(0, 0), b2, voffB);
            PG8_BAR; PG8_WAIT_L(0); PG8_MMA(0, 1, At, B1); PG8_BAR;
            PG8_LDA(At, 0, 1); PG8_STAGE(PG8_SA(0, 0), a2, voffA);
            PG8_BAR; PG8_WAIT_L(0); PG8_MMA(1, 0, At, B0); PG8_BAR; PG8_SCHED;
            PG8_STAGE(PG8_SB(0, 1), b2 + hstep, voffB);
            PG8_WAIT_V(6); PG8_BAR; PG8_MMA(1, 1, At, B1); PG8_BAR;
            PG8_LDB(B0, 1, 0); PG8_SCHED; PG8_LDA(At, 1, 0); PG8_STAGE(PG8_SA(0, 1), a2 + hstep, voffA);
            PG8_WAIT_L(8); PG8_BAR; PG8_WAIT_L(0); PG8_MMA(0, 0, At, B0); PG8_BAR; PG8_SCHED;
            PG8_LDB(B1, 1, 1); PG8_STAGE(PG8_SB(1, 0), b3, voffB);
            PG8_BAR; PG8_WAIT_L(0); PG8_MMA(0, 1, At, B1); PG8_BAR;
            PG8_LDA(At, 1, 1); PG8_STAGE(PG8_SA(1, 0), a3, voffA);
            PG8_BAR; PG8_WAIT_L(0); PG8_MMA(1, 0, At, B0); PG8_BAR; PG8_SCHED;
            PG8_STAGE(PG8_SB(1, 1), b3 + hstep, voffB);
            PG8_WAIT_V(6); PG8_BAR; PG8_MMA(1, 1, At, B1); PG8_BAR;
            }
        }
        if constexpr (ALIGN_EPI) { if (wr == 0) PG8_BAR; }
        if constexpr (!Epi::AFTER_DRAIN) { E(acc, cur, wr, wc, fr, fq); S.done(cur); }
        if (!has_next) break;
#pragma unroll
        for (int a = 0; a < 2; ++a)
#pragma unroll
            for (int b = 0; b < 2; ++b)
#pragma unroll
                for (int m = 0; m < 4; ++m)
#pragma unroll
                    for (int n = 0; n < 2; ++n) acc[a][b][m][n] = (f32x4){0.f, 0.f, 0.f, 0.f};
        cur = nxt; cA = nA; cB = nB; ++ui;
        if constexpr (ALIGN_EPI) { if (wr == 1) PG8_BAR; }
    }
    PG8_WAIT_V(0);
    if constexpr (!ALIGN_EPI) { if (wr == 0) PG8_BAR; }
    PG8_BAR;
    if constexpr (Epi::AFTER_DRAIN) { E.fused(acc, cur, wr, wc, fr, fq, lds, wid, lane); S.done(cur); }
#undef PG8_SA
#undef PG8_SB
#undef PG8_STAGE
#undef PG8_LDA
#undef PG8_LDB
#undef PG8_MMA
#undef PG8_WAIT_V
#undef PG8_WAIT_L
#undef PG8_BAR
#undef PG8_SCHED
}
}

namespace cg = cooperative_groups;
#define GAS __attribute__((address_space(1)))
#define LAS __attribute__((address_space(3)))
typedef unsigned short bf16;
typedef float f32x4 __attribute__((ext_vector_type(4)));
typedef unsigned u32x4 __attribute__((ext_vector_type(4)));
typedef unsigned u32x2 __attribute__((ext_vector_type(2)));
typedef short bf16x8 __attribute__((ext_vector_type(8)));

constexpr int NT = 512, NWAVES = 8;
constexpr int BATCH = 8, SEQ = 8192, D = 1024, FF = 2816, DIN = 2048, DEPTH = 4, M = BATCH * SEQ, CHUNK = 128;
constexpr int NCHUNK = M / CHUNK;
#ifndef MK_NSPLIT
#define MK_NSPLIT 2
#endif
constexpr int NSPLIT = MK_NSPLIT, MH = M / NSPLIT;
constexpr int NPHASE = DEPTH * 7 * NSPLIT + 2;
constexpr size_t MiB = 1u << 20;
constexpr size_t WS_CTL = 0;
constexpr size_t WS_SS = 1 * MiB;
constexpr size_t WS_POOLT = 8 * MiB;
constexpr size_t WS_WSB = 8 * MiB + 512 * 1024;
constexpr size_t WS_W = 10 * MiB;
constexpr size_t W_LAYER = 39 * MiB;
constexpr size_t WO_13A = 0, WO_2A = WO_13A + (size_t)2 * FF * D * 2, WO_IN = WO_2A + (size_t)D * FF * 2, WO_OUT = WO_IN + (size_t)DIN * D * 2,
                 WO_13B = WO_OUT + (size_t)D * D * 2, WO_2B = WO_13B + (size_t)2 * FF * D * 2;
static_assert(WO_2B + (size_t)D * FF * 2 == W_LAYER, "weight map");
constexpr size_t WS_XB = WS_W + DEPTH * W_LAYER;
constexpr size_t WS_R = WS_XB + (size_t)M * D * 2;
constexpr size_t WS_P = WS_R, WS_MIX = WS_R + (size_t)MH * DIN * 2;
constexpr size_t WS_END = WS_R + (size_t)MH * (DIN + D) * 2;
static_assert((size_t)MH * FF * 2 <= (size_t)MH * (DIN + D) * 2, "U fits the block region");
constexpr int LDS_BYTES = 147456;

struct Args { const float* in[24]; float* out; unsigned char* ws; int ph_lo, ph_hi; };

__device__ __forceinline__ float bf_lo(unsigned w) { return __uint_as_float(w << 16); }
__device__ __forceinline__ float bf_hi(unsigned w) { return __uint_as_float(w & 0xffff0000u); }
__device__ __forceinline__ unsigned f2bf(float f) { unsigned u = __float_as_uint(f); return (u + 0x7fffu + ((u >> 16) & 1u)) >> 16; }
__device__ __forceinline__ unsigned pk2(float lo, float hi) { return pg8::cvt_pk_bf16(lo, hi); }
__device__ __forceinline__ float wave_sum(float v) {
    v += __builtin_bit_cast(float, __builtin_amdgcn_update_dpp(0, __builtin_bit_cast(int, v), 0xB1, 0xf, 0xf, false));
    v += __builtin_bit_cast(float, __builtin_amdgcn_update_dpp(0, __builtin_bit_cast(int, v), 0x4E, 0xf, 0xf, false));
    v += __builtin_bit_cast(float, __builtin_amdgcn_update_dpp(0, __builtin_bit_cast(int, v), 0x141, 0xf, 0xf, false));
    v += __builtin_bit_cast(float, __builtin_amdgcn_update_dpp(0, __builtin_bit_cast(int, v), 0x140, 0xf, 0xf, false));
    v += __shfl_xor(v, 16); v += __shfl_xor(v, 32);
    return v;
}
#define LDS_WAIT() asm volatile("s_waitcnt lgkmcnt(0)" ::: "memory")

__device__ __noinline__ void conv_matrix(const float* __restrict__ W, const float* __restrict__ gain, int K, int N, bf16* __restrict__ WT, int mode, int gtid, int nthr, int half) {
    const int total = (K >> 3) * N, i_lo = half == 1 ? total / 2 : 0, i_hi = half == 0 ? total / 2 : total;
#pragma unroll 2
    for (int i = i_lo + gtid; i < i_hi; i += nthr) { const int k8 = i / N, n = i - k8 * N, k0 = k8 * 8; const float* src = W + (size_t)k0 * N + n;
        float v[8];
#pragma unroll
        for (int e = 0; e < 8; ++e) v[e] = src[(size_t)e * N];
        if (gain) {
#pragma unroll
            for (int e = 0; e < 8; ++e) v[e] *= gain[k0 + e]; }
        const int row = mode == 0 ? n : (256 * (n >> 7) + (n & 127) + (mode == 2 ? 128 : 0));
        u32x4 o; o.x = pk2(v[0], v[1]); o.y = pk2(v[2], v[3]); o.z = pk2(v[4], v[5]); o.w = pk2(v[6], v[7]);
        *(u32x4*)(WT + (size_t)row * K + k0) = o; }
}

__device__ __forceinline__ void conv_layer(const Args& a, int l, int group, int gtid, int nthr, int half) {
    unsigned char* wl = a.ws + WS_W + (size_t)l * W_LAYER; const size_t oUP = (size_t)l * D * FF, oDN = (size_t)l * FF * D;
    if (group != 1) {
        conv_matrix(a.in[2] + oUP, a.in[1] + l * D, D, FF, (bf16*)(wl + WO_13A), 1, gtid, nthr, half);
        conv_matrix(a.in[3] + oUP, a.in[1] + l * D, D, FF, (bf16*)(wl + WO_13A), 2, gtid, nthr, half);
        conv_matrix(a.in[4] + oDN, nullptr, FF, D, (bf16*)(wl + WO_2A), 0, gtid, nthr, half);
        conv_matrix(a.in[6] + (size_t)l * D * DIN, a.in[5] + l * D, D, DIN, (bf16*)(wl + WO_IN), 0, gtid, nthr, half);
        conv_matrix(a.in[18] + (size_t)l * D * D, nullptr, D, D, (bf16*)(wl + WO_OUT), 0, gtid, nthr, half); }
    if (group != 0) {
        conv_matrix(a.in[20] + oUP, a.in[19] + l * D, D, FF, (bf16*)(wl + WO_13B), 1, gtid, nthr, half);
        conv_matrix(a.in[21] + oUP, a.in[19] + l * D, D, FF, (bf16*)(wl + WO_13B), 2, gtid, nthr, half);
        conv_matrix(a.in[22] + oDN, nullptr, FF, D, (bf16*)(wl + WO_2B), 0, gtid, nthr, half); }
}

__device__ __forceinline__ void prologue(const Args& a, LAS unsigned char* lds, int G, int bid, int tid, int wave, int lane) {
    unsigned char* ws = a.ws;
    const int gw = bid * NWAVES + wave, NGW = G * NWAVES;
    { f32x4* z = (f32x4*)(ws + WS_SS + (size_t)M * 8); const int n4 = 12 * M / 2;
      for (int i = bid * NT + tid; i < n4; i += G * NT) z[i] = (f32x4){0.f, 0.f, 0.f, 0.f}; }
    { const float* x = a.in[0]; bf16* xb = (bf16*)(ws + WS_XB); unsigned long long* ss0 = (unsigned long long*)(ws + WS_SS);
      for (int m0 = gw * 4; m0 < M; m0 += NGW * 4) { f32x4 v[4][4];
#pragma unroll
          for (int r = 0; r < 4; ++r)
#pragma unroll
              for (int j = 0; j < 4; ++j) v[r][j] = *((const f32x4*)(x + (size_t)(m0 + r) * D) + lane + 64 * j);
#pragma unroll
          for (int r = 0; r < 4; ++r) { float q = 0.f; u32x2* o8 = (u32x2*)(xb + (size_t)(m0 + r) * D) + lane;
#pragma unroll
              for (int j = 0; j < 4; ++j) { const f32x4 t = v[r][j]; q += (t.x * t.x + t.y * t.y) + (t.z * t.z + t.w * t.w); u32x2 o; o.x = pk2(t.x, t.y); o.y = pk2(t.z, t.w); o8[64 * j] = o; }
              q = wave_sum(q); if (lane == 0) ss0[m0 + r] = pg8::ss_fix(q); } } }
    { const int gtid = bid * NT + tid, nthr = G * NT; const int nl = DEPTH;
      for (int l = 0; l < nl; ++l) conv_layer(a, l, -1, gtid, nthr, -1); }
    { bf16* pt = (bf16*)(ws + WS_POOLT); const float* pw = a.in[12];
      for (int i = bid * NT + tid; i < DEPTH * 4 * 64 * 64; i += G * NT) { const int c = i & 63, d = (i >> 6) & 63, lg = i >> 12; pt[i] = (bf16)f2bf(pw[(size_t)lg * 4096 + c * 64 + d]); }
      bf16* wsb = (bf16*)(ws + WS_WSB); const float* w = a.in[16];
      for (int i = bid * NT + tid; i < DEPTH * 4 * 128 * 128; i += G * NT) { const int s = i & 127, t = (i >> 7) & 127; wsb[i] = (s <= t) ? (bf16)f2bf(w[i]) : (bf16)0; } }
}

#ifndef MIX_A
#define MIX_A 1
#define MIX_B 1
#define MIX_C 1
#define MIX_D 1
#endif
__device__ __forceinline__ void mixer_chunk(const Args& a, LAS unsigned char* lds, int l, int ch, int rowbase, int tid_in, int wave, int lane_in) {
    int tid = tid_in; asm volatile("" : "+v"(tid));
    const int lane = tid & 63; (void)lane_in;
    unsigned char* ws = a.ws;
    const bf16* P = (const bf16*)(ws + WS_P) - (size_t)rowbase * DIN; bf16* MIX = (bf16*)(ws + WS_MIX) - (size_t)rowbase * D;
    const int row0 = ch * CHUNK, pos0 = row0 % SEQ, fr = lane & 15, fq = lane >> 4;
#if MIX_A
    {
        const float* cw = a.in[7] + (size_t)l * 31 * 256 + 4 * lane;
        f32x4 w[31];
#pragma unroll
        for (int k = 0; k < 31; ++k) w[k] = *(const f32x4*)(cw + k * 256);
        const f32x4 cb = *(const f32x4*)(a.in[8] + l * 256 + 4 * lane), lg = *(const f32x4*)(a.in[9] + l * 256 + 4 * lane), lb = *(const f32x4*)(a.in[10] + l * 256 + 4 * lane);
#pragma unroll 5
        for (int it = 0; it < 10; ++it) { const int i = it * 16 + (tid >> 5), c8 = (tid & 31) * 8;
            if (i < 158) { u32x4 o = (u32x4){0u, 0u, 0u, 0u};
                if (pos0 + i - 30 >= 0) { const bf16* pr = P + (size_t)(row0 + i - 30) * DIN; const u32x4 v = *(const u32x4*)(pr + c8), g = *(const u32x4*)(pr + 256 + c8);
#pragma unroll
                    for (int e = 0; e < 4; ++e) o[e] = pk2(bf_lo(v[e]) * pg8::fast_sigmoid(bf_lo(g[e])), bf_hi(v[e]) * pg8::fast_sigmoid(bf_hi(g[e]))); }
                *(LAS u32x4*)(lds + i * 512 + c8 * 2) = o; } }
        __syncthreads();
#pragma unroll 1
        for (int half = 0; half < 2; ++half) { const int jb = 16 * wave + 8 * half;
            f32x4 acc[8];
#pragma unroll
            for (int j = 0; j < 8; ++j) acc[j] = cb;
#pragma unroll
            for (int ii = 0; ii < 38; ++ii) { const u32x2 raw = *(const LAS u32x2*)(lds + (jb + ii) * 512 + lane * 8);
                const f32x4 y = (f32x4){bf_lo(raw.x), bf_hi(raw.x), bf_lo(raw.y), bf_hi(raw.y)};
#pragma unroll
                for (int j = 0; j < 8; ++j) { const int k = ii - j; if (k >= 0 && k <= 30) acc[j] += w[k] * y; }
                if ((ii & 3) == 3) __builtin_amdgcn_sched_barrier(0); }
#pragma unroll
            for (int j = 0; j < 8; ++j) { const float mean = wave_sum((acc[j].x + acc[j].y) + (acc[j].z + acc[j].w)) * (1.0f / 256.0f);
                const f32x4 d = acc[j] - mean; const float var = wave_sum((d.x * d.x + d.y * d.y) + (d.z * d.z + d.w * d.w)) * (1.0f / 256.0f);
                const float rstd = __builtin_amdgcn_rsqf(var + 1e-6f); const f32x4 o = d * rstd * lg + lb;
                u32x2 pk; pk.x = pk2(pg8::fast_silu(o.x), pg8::fast_silu(o.y)); pk.y = pk2(pg8::fast_silu(o.z), pg8::fast_silu(o.w));
                *(u32x2*)(MIX + (size_t)(row0 + jb + j) * D + 4 * lane) = pk; } }
    }
#endif

#if MIX_B
    {
        const float* sw = a.in[11] + (size_t)l * 3 * 256; const int c8 = (tid & 31) * 8, tl0 = (tid >> 5) * 8;
        f32x4 w0[2], w1[2], w2[2];
#pragma unroll
        for (int hh = 0; hh < 2; ++hh) { w0[hh] = *(const f32x4*)(sw + c8 + 4 * hh); w1[hh] = *(const f32x4*)(sw + 256 + c8 + 4 * hh); w2[hh] = *(const f32x4*)(sw + 512 + c8 + 4 * hh); }
        const bf16* pr0 = P + (size_t)(row0 + tl0) * DIN + c8;
        u32x4 scv[10], sxv[10], sbv[8];
#pragma unroll
        for (int r = 0; r < 10; ++r) { if (pos0 + tl0 + r - 2 >= 0) { scv[r] = *(const u32x4*)(pr0 + (ptrdiff_t)(r - 2) * DIN + 768); sxv[r] = *(const u32x4*)(pr0 + (ptrdiff_t)(r - 2) * DIN + 1024); }
            else { scv[r] = (u32x4){0u, 0u, 0u, 0u}; sxv[r] = (u32x4){0u, 0u, 0u, 0u}; } }
#pragma unroll
        for (int r = 0; r < 8; ++r) sbv[r] = *(const u32x4*)(pr0 + (size_t)r * DIN + 512);
        float za[8], zb[8];
#pragma unroll
        for (int e = 0; e < 4; ++e) { za[2 * e] = bf_lo(scv[0][e]) * bf_lo(sxv[0][e]); za[2 * e + 1] = bf_hi(scv[0][e]) * bf_hi(sxv[0][e]); zb[2 * e] = bf_lo(scv[1][e]) * bf_lo(sxv[1][e]); zb[2 * e + 1] = bf_hi(scv[1][e]) * bf_hi(sxv[1][e]); }
#pragma unroll
        for (int r = 0; r < 8; ++r) { float zc[8], o[8];
#pragma unroll
            for (int e = 0; e < 4; ++e) { zc[2 * e] = bf_lo(scv[r + 2][e]) * bf_lo(sxv[r + 2][e]); zc[2 * e + 1] = bf_hi(scv[r + 2][e]) * bf_hi(sxv[r + 2][e]); }
#pragma unroll
            for (int hh = 0; hh < 2; ++hh)
#pragma unroll
                for (int e = 0; e < 4; ++e) o[4 * hh + e] = w0[hh][e] * za[4 * hh + e] + w1[hh][e] * zb[4 * hh + e] + w2[hh][e] * zc[4 * hh + e];
            u32x4 pk;
#pragma unroll
            for (int e = 0; e < 4; ++e) pk[e] = pk2(bf_lo(sbv[r][e]) * o[2 * e], bf_hi(sbv[r][e]) * o[2 * e + 1]);
            *(u32x4*)(MIX + (size_t)(row0 + tl0 + r) * D + 256 + c8) = pk;
#pragma unroll
            for (int e = 0; e < 8; ++e) { za[e] = zb[e]; zb[e] = zc[e]; } }
    }
#endif

    __syncthreads();
#if MIX_C
    {
        constexpr int PITCH = 528;
#pragma unroll 9
        for (int it = 0; it < 9; ++it) { const int idx = it * NT + tid;
            if (idx < 143 * 32) { const int i = idx >> 5, c8 = (idx & 31) * 8; u32x4 v = (u32x4){0u, 0u, 0u, 0u};
                if (pos0 + i - 15 >= 0) v = *(const u32x4*)(P + (size_t)(row0 + i - 15) * DIN + 1280 + c8);
                *(LAS u32x4*)(lds + i * PITCH + c8 * 2) = v; } }
        __syncthreads();
        const int tl = 16 * wave + fr, pos = pos0 + tl, i0 = tl + 15;
        const bf16* poolT = (const bf16*)(ws + WS_POOLT) + (size_t)l * 4 * 4096; const float* pscale = a.in[13] + l * 256;
#pragma unroll 1
        for (int g = 0; g < 4; ++g) { const int wlen = 2 << g;
            f32x4 acc[4];
#pragma unroll
            for (int nb = 0; nb < 4; ++nb) acc[nb] = (f32x4){0.f, 0.f, 0.f, 0.f};
            const float inv = 1.0f / (float)((pos + 1) < wlen ? (pos + 1) : wlen);
#pragma unroll 1
            for (int kk = 0; kk < 2; ++kk) { const int cbase = 64 * g + 32 * kk + 8 * fq;
                float s[8], cur[8];
                { const u32x4 raw = *(const LAS u32x4*)(lds + i0 * PITCH + cbase * 2);
#pragma unroll
                  for (int e = 0; e < 4; ++e) { cur[2 * e] = bf_lo(raw[e]); cur[2 * e + 1] = bf_hi(raw[e]); s[2 * e] = cur[2 * e]; s[2 * e + 1] = cur[2 * e + 1]; } }
#pragma unroll 2
                for (int jj = 1; jj < wlen; ++jj) { const u32x4 raw = *(const LAS u32x4*)(lds + (i0 - jj) * PITCH + cbase * 2);
#pragma unroll
                    for (int e = 0; e < 4; ++e) { s[2 * e] += bf_lo(raw[e]); s[2 * e + 1] += bf_hi(raw[e]); } }
                u32x4 yp;
#pragma unroll
                for (int e = 0; e < 4; ++e) yp[e] = pk2(s[2 * e] * inv - cur[2 * e], s[2 * e + 1] * inv - cur[2 * e + 1]);
                const bf16x8 Y = __builtin_bit_cast(bf16x8, yp);
#pragma unroll
                for (int nb = 0; nb < 4; ++nb) { const bf16x8 X = *(const bf16x8*)(poolT + (size_t)(g * 64 + 16 * nb + fr) * 64 + 32 * kk + 8 * fq);
                    acc[nb] = __builtin_amdgcn_mfma_f32_16x16x32_bf16(X, Y, acc[nb], 0, 0, 0); } }
#pragma unroll
            for (int nb = 0; nb < 4; ++nb) { const int col = 64 * g + 16 * nb + 4 * fq; const f32x4 sc = *(const f32x4*)(pscale + col); const f32x4 o = acc[nb] * sc;
                u32x2 pk; pk.x = pk2(o.x, o.y); pk.y = pk2(o.z, o.w);
                *(u32x2*)(MIX + (size_t)(row0 + tl) * D + 512 + col) = pk; } }
    }
#endif

    __syncthreads();
#if MIX_D
    {
        constexpr int VP = 272;
        const float* lg = a.in[14] + l * 256; const float* lb = a.in[15] + l * 256;
        float gg[4], bb[4];
#pragma unroll
        for (int j = 0; j < 4; ++j) { gg[j] = lg[lane + 64 * j]; bb[j] = lb[lane + 64 * j]; }
#pragma unroll 8
        for (int tt = 0; tt < 16; ++tt) { const int tl = 16 * wave + tt; const bf16* pr = P + (size_t)(row0 + tl) * DIN + 1792;
            float x[4];
#pragma unroll
            for (int j = 0; j < 4; ++j) x[j] = __uint_as_float(((unsigned)pr[lane + 64 * j]) << 16);
            const float mean = wave_sum((x[0] + x[1]) + (x[2] + x[3])) * (1.0f / 256.0f);
#pragma unroll
            for (int j = 0; j < 4; ++j) x[j] -= mean;
            const float var = wave_sum((x[0] * x[0] + x[1] * x[1]) + (x[2] * x[2] + x[3] * x[3])) * (1.0f / 256.0f);
            const float rstd = __builtin_amdgcn_rsqf(var + 1e-6f);
#pragma unroll
            for (int j = 0; j < 4; ++j) *(LAS bf16*)(lds + (lane + 64 * j) * VP + tl * 2) = (bf16)f2bf(x[j] * rstd * gg[j] + bb[j]); }
        __syncthreads();
        const bf16* wsb = (const bf16*)(ws + WS_WSB) + (size_t)l * 4 * 128 * 128; const float* bs = a.in[17] + (size_t)l * 4 * 128;
        const int t = 16 * wave + fr; const bf16* pu = P + (size_t)(row0 + t) * DIN + 1536; bf16* po = MIX + (size_t)(row0 + t) * D + 768;
#pragma unroll 1
        for (int h = 0; h < 4; ++h) { bf16x8 Y[4];
#pragma unroll
            for (int kk = 0; kk < 4; ++kk) Y[kk] = *(const bf16x8*)(wsb + ((size_t)(h * 128 + t)) * 128 + 32 * kk + 8 * fq);
            const float bias = bs[h * 128 + t];
#pragma unroll
            for (int cb = 0; cb < 4; ++cb) { f32x4 acc = (f32x4){0.f, 0.f, 0.f, 0.f};
#pragma unroll
                for (int kk = 0; kk < 4; ++kk) if (kk <= (wave >> 1)) { const bf16x8 X = *(const LAS bf16x8*)(lds + (64 * h + 16 * cb + fr) * VP + (32 * kk + 8 * fq) * 2);
                    acc = __builtin_amdgcn_mfma_f32_16x16x32_bf16(X, Y[kk], acc, 0, 0, 0); }
                const int c = 64 * h + 16 * cb + 4 * fq; const u32x2 gu = *(const u32x2*)(pu + c);
                u32x2 pk; pk.x = pk2(bf_lo(gu.x) * (acc.x + bias), bf_hi(gu.x) * (acc.y + bias)); pk.y = pk2(bf_lo(gu.y) * (acc.z + bias), bf_hi(gu.y) * (acc.w + bias));
                *(u32x2*)(po + c) = pk; } }
    }
#endif

    __syncthreads();
}

typedef GAS unsigned gu32;
#define XB_TMO      128
#define XB_XCNT(j)  (256  + 64 * (j))
#define XB_XSUB(j)  (1280 + 64 * (j))
#define XB_XGEN(j)  (2304 + 64 * (j))
#define XB_TOP      3328
#define XB_TOPGEN   3392
#define XCD_BAR_WORDS 3456
#define XB_SPIN_CAP (1u << 18)

__device__ __forceinline__ unsigned xb_ld(unsigned* p)              { return __hip_atomic_load(p, __ATOMIC_RELAXED, __HIP_MEMORY_SCOPE_AGENT); }
__device__ __forceinline__ unsigned xb_add(unsigned* p, unsigned v) { return __hip_atomic_fetch_add(p, v, __ATOMIC_RELAXED, __HIP_MEMORY_SCOPE_AGENT); }
__device__ __forceinline__ unsigned xb_xcc_id() { return (unsigned)__builtin_amdgcn_s_getreg((3 << 11) | 20) & 0xFu; }
#define XB_SPIN(cond, bar) do { unsigned _sp = 0; while (cond) { __builtin_amdgcn_s_sleep(1); \
    if ((++_sp & 255u) == 0u) { if (xb_ld(&(bar)[XB_TMO])) break; if (_sp > XB_SPIN_CAP) { atomicAdd(&(bar)[XB_TMO], 1u); break; } } } } while (0)

struct XcdBarrier {
    unsigned* bar; unsigned x;
    volatile LAS unsigned* st;
};

__device__ __forceinline__ XcdBarrier xcd_barrier_post(unsigned* bar, volatile LAS unsigned* st) {
    XcdBarrier b; b.bar = bar; b.x = xb_xcc_id(); b.st = st;
    if (threadIdx.x == 0) (void)xb_add(&bar[XB_XCNT(b.x)], 1u);
    return b;
}
__device__ __forceinline__ void xcd_barrier_complete(unsigned* bar, unsigned x, unsigned& nloc, unsigned& nx) {
    const unsigned G = gridDim.x * gridDim.y * gridDim.z;
    unsigned sum, cnt, mine, sp = 0u;
    for (;;) {
        sum = 0u; cnt = 0u; mine = 0u;
#pragma unroll
        for (unsigned j = 0; j < 16; ++j) { const unsigned c = xb_ld(&bar[XB_XCNT(j)]); sum += c; cnt += (c > 0u) ? 1u : 0u; mine = (j == x) ? c : mine; }
        if (sum == G) break;
        __builtin_amdgcn_s_sleep(1);
        if ((++sp & 255u) == 0u) { if (xb_ld(&bar[XB_TMO])) break; if (sp > XB_SPIN_CAP) { atomicAdd(&bar[XB_TMO], 1u); break; } }
    }
    nloc = mine > 0u ? mine : 1u; nx = cnt > 0u ? cnt : 1u;
}

__device__ __forceinline__ void xcd_barrier(const XcdBarrier& b) {
    asm volatile("s_waitcnt vmcnt(0)" ::: "memory");
    __syncthreads();
    if (threadIdx.x == 0) {
        unsigned* bar = b.bar;
        __builtin_amdgcn_s_waitcnt(0);
        unsigned nloc = b.st[0], nx = b.st[1];
        if (nloc == 0u) { xcd_barrier_complete(bar, b.x, nloc, nx); b.st[0] = nloc; b.st[1] = nx; }
        const unsigned old = xb_add(&bar[XB_XSUB(b.x)], 1u);
        const unsigned gen = old / nloc;
        if (old + 1u == (gen + 1u) * nloc) {
            __builtin_amdgcn_fence(__ATOMIC_RELEASE, "agent");
            asm volatile("s_waitcnt vmcnt(0)" ::: "memory");
            const unsigned og = xb_add(&bar[XB_TOP], 1u);
            const unsigned tg = og / nx;
            if (og + 1u == (tg + 1u) * nx) xb_add(&bar[XB_TOPGEN], 1u);
            else XB_SPIN(xb_ld(&bar[XB_TOPGEN]) == tg, bar);
            __builtin_amdgcn_fence(__ATOMIC_ACQUIRE, "agent");
            xb_add(&bar[XB_XGEN(b.x)], 1u);
            asm volatile("s_waitcnt vmcnt(0)" ::: "memory");
        } else {
            XB_SPIN(xb_ld(&bar[XB_XGEN(b.x)]) == gen, bar);
            __builtin_amdgcn_fence(__ATOMIC_ACQUIRE, "agent");
            asm volatile("s_waitcnt vmcnt(0)" ::: "memory");
        }
    }
    __syncthreads();
}

#define GB_MASK(g) (4096 + 64 * (g))
#define GB_CNT(g)  (4096 + 512 + 64 * (g))
#define GB_GEN(g)  (4096 + 1024 + 64 * (g))
#define CTL_WORDS  6144
__device__ __noinline__ void group_barrier(unsigned* bar, unsigned g, unsigned nmem) {
    asm volatile("s_waitcnt vmcnt(0)" ::: "memory");
    __syncthreads();
    if (threadIdx.x == 0) {
        const unsigned old = xb_add(&bar[GB_CNT(g)], 1u), gen = old / nmem;
        if (old + 1u == (gen + 1u) * nmem) xb_add(&bar[GB_GEN(g)], 1u);
        else XB_SPIN(xb_ld(&bar[GB_GEN(g)]) == gen, bar);
        __builtin_amdgcn_fence(__ATOMIC_ACQUIRE, "agent");
        asm volatile("s_waitcnt vmcnt(0)" ::: "memory");
    }
    __syncthreads();
}
#ifndef PROBE_ZERO
#define PROBE_ZERO 0
#endif
#ifndef PROBE_MIX2
#define PROBE_G1 0
#define PROBE_G2 0
#define PROBE_G3 0
#define PROBE_G4 0
#define PROBE_MIX2 0
#define PROBE_PRO2 0
#define PROBE_SYNC2 0
#endif
#define GRID_SYNC_CG() do { asm volatile("s_waitcnt vmcnt(0)" ::: "memory"); grid.sync(); } while (0)
#define GRID_SYNC() xcd_barrier(xbar)
__global__ void __launch_bounds__(NT, 2) mk_fwd(Args a) {
    extern __shared__ __attribute__((aligned(16))) unsigned char lds_raw[];
    LAS unsigned char* lds = (LAS unsigned char*)lds_raw;
    cg::grid_group grid = cg::this_grid();
    const int tid0 = threadIdx.x, wave = __builtin_amdgcn_readfirstlane(tid0 >> 6), G = gridDim.x, bid = blockIdx.x;
    unsigned char* ws = a.ws;
    unsigned long long* ssb = (unsigned long long*)(ws + WS_SS); bf16* xb = (bf16*)(ws + WS_XB); bf16* U = (bf16*)(ws + WS_R); bf16* Pb = (bf16*)(ws + WS_P); bf16* MIXb = (bf16*)(ws + WS_MIX);
    float* xf = a.out;
    volatile LAS unsigned* xb_st = (volatile LAS unsigned*)(lds + 131072 + 64);
    if (tid0 < 3) xb_st[tid0] = 0u;
    if (bid == 0) for (int i = tid0; i < CTL_WORDS; i += NT) ((unsigned*)(ws + WS_CTL))[i] = 0u;
    __syncthreads();
    XcdBarrier xbar; xbar.bar = (unsigned*)(ws + WS_CTL); xbar.x = 0; xbar.st = xb_st;

    for (int pp = a.ph_lo; pp < a.ph_hi; ++pp) {
        int tid = tid0; asm volatile("" : "+v"(tid)); const int lane = tid & 63;
        if (pp == 0) { prologue(a, lds, G, bid, tid, wave, lane);
#if PROBE_PRO2
            __syncthreads(); prologue(a, lds, G, bid, tid, wave, lane);
#endif
        }
        else if (pp == NPHASE - 1) {
            const unsigned long long* ss = ssb + (size_t)12 * M; const float* gain = a.in[23]; const int gw = bid * NWAVES + wave, NGW = G * NWAVES;
            f32x4 gv[4];
#pragma unroll
            for (int j = 0; j < 4; ++j) gv[j] = *((const f32x4*)gain + lane + 64 * j);
            for (int m = gw; m < M; m += NGW) { f32x4* orow = (f32x4*)(xf + (size_t)m * D) + lane; const u32x2* xr = (const u32x2*)(xb + (size_t)m * D) + lane; const float r = pg8::ss_rnorm(ss[m]);
#pragma unroll
                for (int j = 0; j < 4; ++j) { const u32x2 v = xr[64 * j]; orow[64 * j] = (f32x4){bf_lo(v.x), bf_hi(v.x), bf_lo(v.y), bf_hi(v.y)} * r * gv[j]; } }
        } else {
        const int ph = pp - 1;
        const int hb = ph / (7 * DEPTH), l = (ph / 7) % DEPTH, st = ph % 7; const unsigned char* wl = ws + WS_W + (size_t)l * W_LAYER;
        const size_t r0 = (size_t)hb * MH; bf16* xbh = xb + r0 * D;
        if (st == 0 || st == 5) {
            const int si = 3 * l + (st == 0 ? 0 : 2);
            pg8::Gemm g{xbh, (const bf16*)(wl + (st == 0 ? WO_13A : WO_13B)), MH, 2 * FF, D}; pg8::StaticOrder S; S.init(MH, 2 * FF, G, bid);
            pg8::EpiSwiglu E{U, ssb + (size_t)si * M + r0, 0};
#if PROBE_ZERO
            if (ph == 0) { pg8::Gemm gz = g; pg8::EpiSwiglu Ez = E; Ez.cheap = 1; gz.pm_mask = 3; gz.pn_mask = 3;
#if PROBE_ZERO == 1
                gz.A = (const bf16*)(ws + WS_SS + (size_t)M * 8); gz.Bt = (const bf16*)(ws + WS_SS + (size_t)M * 8 + 2 * MiB);
#endif
                pg8::gemm_phase<pg8::EpiSwiglu, pg8::StaticOrder, true, true>(lds, gz, S, Ez); GRID_SYNC(); }
#endif
            for (int rep_ = 0; rep_ < 1 + (PROBE_G1 ? 1 : 0); ++rep_) { if (rep_) GRID_SYNC(); E.cheap = (PROBE_G1 >= 2 && rep_ == 0) ? 1 : 0; g.pm_mask = (PROBE_G1 == 3 && rep_ == 0) ? 0 : -1; g.pn_mask = (PROBE_G1 == 4 && rep_ == 0) ? 0 : ((PROBE_G1 == 3 && rep_ == 0) ? 3 : -1);
            pg8::gemm_phase<pg8::EpiSwiglu, pg8::StaticOrder, true, true>(lds, g, S, E); }
        } else if (st == 1 || st == 4 || st == 6) {
            const int so = 3 * l + (st == 1 ? 1 : (st == 4 ? 2 : 3));
            pg8::Gemm g{st == 4 ? MIXb : U, (const bf16*)(wl + (st == 1 ? WO_2A : (st == 4 ? WO_OUT : WO_2B))), MH, D, st == 4 ? D : FF}; pg8::StaticOrder S; S.init(MH, D, G, bid);
            pg8::EpiResid E{xbh, ssb + (size_t)so * M + r0, st == 4 ? 1.0f : 0.5f, 0};
            const int nrep = 1 + ((st == 4) ? PROBE_G4 : PROBE_G2);
            const bool shift = false; const int setB = (bid >> 3) & 1, srank = (bid & 7) + 8 * (bid >> 4);
            if (shift && setB) conv_layer(a, l + 1, st == 1 ? 0 : 1, srank * NT + tid, (G / 2) * NT, 0);
            for (int rep_ = 0; rep_ < nrep; ++rep_) { if (rep_) GRID_SYNC(); E.dry = (rep_ + 1 < nrep) ? 1 : 0;
            pg8::gemm_phase<pg8::EpiResid, pg8::StaticOrder, true, true>(lds, g, S, E); }
            if (shift && !setB) conv_layer(a, l + 1, st == 1 ? 0 : 1, srank * NT + tid, (G / 2) * NT, 1);
        } else if (st == 2) {
            pg8::Gemm g{xbh, (const bf16*)(wl + WO_IN), MH, DIN, D}; pg8::StaticOrder S; S.init(MH, DIN, G, bid);
            pg8::EpiScale E{Pb, DIN, ssb + (size_t)(3 * l + 1) * M + r0};
            for (int rep_ = 0; rep_ < 1 + PROBE_G3; ++rep_) { if (rep_) GRID_SYNC();
            pg8::gemm_phase<pg8::EpiScale, pg8::StaticOrder, true, true>(lds, g, S, E); }
        } else {
            for (int rep_ = 0; rep_ < 1 + PROBE_MIX2; ++rep_)
            for (int c0 = bid; c0 < NCHUNK / NSPLIT; c0 += G) { const int ch = (G == 256 && NCHUNK / NSPLIT == 256) ? 32 * (c0 & 7) + (c0 >> 3) : c0;
                mixer_chunk(a, lds, l, hb * (NCHUNK / NSPLIT) + ch, (int)r0, tid, wave, lane); }
        }
        }
        if (pp + 1 < a.ph_hi) {
            if (pp == 0) { GRID_SYNC_CG(); xbar = xcd_barrier_post((unsigned*)(ws + WS_CTL), xb_st);
                if (tid0 == 0) atomicOr((unsigned*)(ws + WS_CTL) + GB_MASK(bid & 7), 1u << xbar.x); }
            else if (pp == 1) { GRID_SYNC();
                if (tid0 == 0) { bool one = (G == 256 && NCHUNK / NSPLIT == 256);
                    for (int g_ = 0; g_ < 8; ++g_) one = one && __builtin_popcount(xb_ld((unsigned*)(ws + WS_CTL) + GB_MASK(g_))) == 1;
                    xb_st[2] = one ? 1u : 0u; }
                __syncthreads(); }
            else { const int st_ = (pp - 1) % 7; const bool light = __builtin_amdgcn_readfirstlane((int)xb_st[2]) != 0 && (st_ == 0 || st_ == 3 || st_ == 5 || st_ == 6) && pp + 2 < NPHASE;
                if (light) group_barrier((unsigned*)(ws + WS_CTL), (unsigned)(bid & 7), (unsigned)(G / 8)); else GRID_SYNC(); }
#if PROBE_SYNC2
            GRID_SYNC();
#endif
        }
    }
}

extern "C" void kernel_launch(void* const* d_in, const int* in_sizes, int n_in, void* d_out, int out_size, void* d_ws, size_t ws_size, hipStream_t stream) {
    static int grid = 0;
    if (grid == 0) {
        if (n_in != 24 || out_size != M * D || ws_size < WS_END) { fprintf(stderr, "kernel_launch: unexpected shapes (n_in %d out %d ws %zu)\n", n_in, out_size, ws_size); grid = -1; return; }
        int dev = 0, cus = 0, per_cu = 0;
        hipGetDevice(&dev); hipDeviceGetAttribute(&cus, hipDeviceAttributeMultiprocessorCount, dev);
        if (hipFuncSetAttribute((const void*)mk_fwd, hipFuncAttributeMaxDynamicSharedMemorySize, LDS_BYTES) != hipSuccess) { fprintf(stderr, "kernel_launch: hipFuncSetAttribute failed\n"); grid = -1; return; }
        if (hipOccupancyMaxActiveBlocksPerMultiprocessor(&per_cu, (const void*)mk_fwd, NT, LDS_BYTES) != hipSuccess || per_cu < 1) { fprintf(stderr, "kernel_launch: occupancy query gave %d\n", per_cu); per_cu = 1; }
        (void)hipGetLastError();
        grid = cus * per_cu;
    }
    if (grid < 0) return;
    Args a{};
    for (int i = 0; i < 24; ++i) a.in[i] = (const float*)d_in[i];
    a.out = (float*)d_out; a.ws = (unsigned char*)d_ws;
#ifndef MK_PER_PHASE
#define MK_PER_PHASE 0
#endif
#if MK_PER_PHASE
    for (int p = 0; p < DEPTH * 7 + 2; ++p) { a.ph_lo = p; a.ph_hi = p + 1; hipLaunchKernelGGL(mk_fwd, dim3(grid), dim3(NT), LDS_BYTES, stream, a); }
#else
    a.ph_lo = 0; a.ph_hi = NPHASE;
    void* args[] = {&a};
    hipError_t e = hipLaunchCooperativeKernel((const void*)mk_fwd, dim3(grid), dim3(NT), args, LDS_BYTES, stream);
    if (e != hipSuccess) fprintf(stderr, "cooperative launch failed: %s (grid %d)\n", hipGetErrorString(e), grid);
#endif
}
```
